# Optimizing an MI355X kernel written in HIP

```python
import math
import jax
import jax.numpy as jnp
from jax import lax
import numpy as np

D_MODEL = 2048
BATCH = 1
SEQ = 16384
DEPTH = 4

GRID_W = 64
CTX_LEN = 256
EPS = 1e-6
NEG_INF = -1e30
ROPE_BASE = 10000.0
ROPE_AXIS_FREQS = 32

DIFF_HEADS = 4
DIFF_DH = 128
SWA_HEADS = 8
SWA_KV_HEADS = 2
SWA_GROUP = SWA_HEADS // SWA_KV_HEADS
SWA_DH = 128
WINDOW = 128
Q_BLOCK = 128
DN_QK_HEADS = 16
DN_V_HEADS = 32
DN_DK = 128
DN_DV = 128
DN_CHUNK = 64
SHORT_CONV_W = 3
FFN_HIDDEN = 5632
FFN_CONV_W = 3

N_EVEN = (DEPTH + 1) // 2
N_ODD = DEPTH // 2

DIFF_OUT = DIFF_HEADS * 2 * DIFF_DH
SWA_OUT = SWA_HEADS * SWA_DH
ATTN_OUT = DIFF_OUT + SWA_OUT
ATTN_IN_SIZES = (DIFF_HEADS * 2 * DIFF_DH, DIFF_HEADS * 2 * DIFF_DH, DIFF_HEADS * 2 * DIFF_DH,
                 SWA_HEADS * SWA_DH, SWA_KV_HEADS * SWA_DH, SWA_KV_HEADS * SWA_DH)
ATTN_IN = sum(ATTN_IN_SIZES)
DN_CONV_CH = 2 * DN_QK_HEADS * DN_DK + DN_V_HEADS * DN_DV
DN_OUT = DN_V_HEADS * DN_DV
DN_GATES = 4 * DN_V_HEADS
DN_IN_SIZES = (DN_CONV_CH, DN_OUT, DN_GATES)
DN_IN = sum(DN_IN_SIZES)

kernel_name = 'hybrid_diffattn_swa_deltanet_convffn_prefix_dit'


def _split(x, sizes):
    return jnp.split(x, np.cumsum(sizes)[:-1].tolist(), axis=-1)


def rmsnorm(x, gain):
    xf = x.astype(jnp.float32)
    y = xf * lax.rsqrt(jnp.mean(xf * xf, axis=-1, keepdims=True) + EPS)
    return (y * gain.astype(jnp.float32)).astype(x.dtype)


def l2norm(x):
    xf = x.astype(jnp.float32)
    return (xf * lax.rsqrt(jnp.sum(xf * xf, axis=-1, keepdims=True) + EPS)).astype(x.dtype)


def modulate(x, shift, scale):
    return x * (1.0 + scale[:, None, :]) + shift[:, None, :]


def dwconv_centred(x, w):
    k = w.shape[0]
    r = k // 2
    n = x.shape[1]
    xp = jnp.pad(x, ((0, 0), (r, r), (0, 0)))
    return sum(xp[:, i:i + n] * w[i] for i in range(k))


def axial_rope_tables(n):
    rows = n // GRID_W
    row = jnp.broadcast_to(jnp.arange(rows)[:, None], (rows, GRID_W)).reshape(-1).astype(jnp.float32)
    col = jnp.broadcast_to(jnp.arange(GRID_W)[None, :], (rows, GRID_W)).reshape(-1).astype(jnp.float32)
    inv = ROPE_BASE ** (-jnp.arange(ROPE_AXIS_FREQS, dtype=jnp.float32) / ROPE_AXIS_FREQS)
    ang = jnp.concatenate([row[:, None] * inv, col[:, None] * inv], axis=-1)
    return jnp.cos(ang), jnp.sin(ang)


def apply_axial_rope(x, cos, sin):
    shp = (1, x.shape[1]) + (1,) * (x.ndim - 3) + (2, ROPE_AXIS_FREQS)
    c = cos.reshape(shp).astype(x.dtype)
    s = sin.reshape(shp).astype(x.dtype)
    xs = x.reshape(x.shape[:-1] + (2, 2, ROPE_AXIS_FREQS))
    x1, x2 = xs[..., 0, :], xs[..., 1, :]
    out = jnp.stack([x1 * c - x2 * s, x2 * c + x1 * s], axis=-2)
    return out.reshape(x.shape)


def diff_attend(q, k, v, lam):
    s = jnp.einsum('bqhmd,bkhmd->bhmqk', q, k).astype(jnp.float32) * (DIFF_DH ** -0.5)
    p = jax.nn.softmax(s, axis=-1)
    w = (p[:, :, 0] - lam * p[:, :, 1]).astype(v.dtype)
    return jnp.einsum('bhqk,bkhe->bqhe', w, v)


def sink_softmax(s, sink):
    m = jnp.maximum(jnp.max(s, axis=-1, keepdims=True), sink)
    e = jnp.exp(s - m)
    return e / (jnp.sum(e, axis=-1, keepdims=True) + jnp.exp(sink - m))


def swa_block(q_blk, b_idx, k_pad, v_pad, k_ctx, v_ctx, sink5, n):
    start = b_idx * Q_BLOCK
    span = Q_BLOCK + 2 * WINDOW
    kw = lax.dynamic_slice_in_dim(k_pad, start, span, axis=1)
    vw = lax.dynamic_slice_in_dim(v_pad, start, span, axis=1)
    scale = SWA_DH ** -0.5
    s_ctx = jnp.einsum('bqkgd,bjkd->bkgqj', q_blk, k_ctx).astype(jnp.float32) * scale
    s_win = jnp.einsum('bqkgd,bjkd->bkgqj', q_blk, kw).astype(jnp.float32) * scale
    qpos = start + jnp.arange(Q_BLOCK)
    kpos = start - WINDOW + jnp.arange(span)
    valid = (jnp.abs(qpos[:, None] - kpos[None, :]) <= WINDOW) & (kpos >= 0)[None, :] & (kpos < n)[None, :]
    s_win = jnp.where(valid, s_win, NEG_INF)
    p = sink_softmax(jnp.concatenate([s_ctx, s_win], axis=-1), sink5).astype(v_ctx.dtype)
    n_ctx = k_ctx.shape[1]
    return (jnp.einsum('bkgqj,bjkd->bqkgd', p[..., :n_ctx], v_ctx)
            + jnp.einsum('bkgqj,bjkd->bqkgd', p[..., n_ctx:], vw))


def swa_ctx(q, k, v, sink5):
    s = jnp.einsum('bqkgd,bjkd->bkgqj', q, k).astype(jnp.float32) * (SWA_DH ** -0.5)
    p = sink_softmax(s, sink5).astype(v.dtype)
    return jnp.einsum('bkgqj,bjkd->bqkgd', p, v)


def attention_mixer(h_lat, h_ctx, w_in, lam_vec, subln_g, sink, w_out, lam_init, cos, sin, need_ctx_out):
    bsz, n, _ = h_lat.shape
    n_ctx = h_ctx.shape[1]
    nb = n // Q_BLOCK

    def project(h):
        bb, nn, _ = h.shape
        qa, ka, va, qb, kb, vb = _split(h @ w_in, ATTN_IN_SIZES)
        return (qa.reshape(bb, nn, DIFF_HEADS, 2, DIFF_DH),
                ka.reshape(bb, nn, DIFF_HEADS, 2, DIFF_DH),
                va.reshape(bb, nn, DIFF_HEADS, 2 * DIFF_DH),
                qb.reshape(bb, nn, SWA_KV_HEADS, SWA_GROUP, SWA_DH),
                kb.reshape(bb, nn, SWA_KV_HEADS, SWA_DH),
                vb.reshape(bb, nn, SWA_KV_HEADS, SWA_DH))

    qa_l, ka_l, va_l, qb_l, kb_l, vb_l = project(h_lat)
    qa_l, ka_l, qb_l, kb_l = (apply_axial_rope(t, cos, sin) for t in (qa_l, ka_l, qb_l, kb_l))
    qa_c, ka_c, va_c, qb_c, kb_c, vb_c = project(h_ctx)

    lf = lam_vec.astype(jnp.float32)
    lam = jnp.exp(jnp.sum(lf[0] * lf[1])) - jnp.exp(jnp.sum(lf[2] * lf[3])) + lam_init

    k_all = jnp.concatenate([ka_c, ka_l], axis=1)
    v_all = jnp.concatenate([va_c, va_l], axis=1)
    qa_blocks = jnp.moveaxis(qa_l.reshape(bsz, nb, Q_BLOCK, DIFF_HEADS, 2, DIFF_DH), 1, 0)
    oa_l = lax.map(lambda qq: diff_attend(qq, k_all, v_all, lam), qa_blocks)
    oa_l = jnp.moveaxis(oa_l, 0, 1).reshape(bsz, n, DIFF_HEADS, 2 * DIFF_DH)

    sink5 = sink.astype(jnp.float32).reshape(1, SWA_KV_HEADS, SWA_GROUP, 1, 1)
    pad = ((0, 0), (WINDOW, WINDOW), (0, 0), (0, 0))
    kb_pad = jnp.pad(kb_l, pad)
    vb_pad = jnp.pad(vb_l, pad)
    qb_blocks = jnp.moveaxis(qb_l.reshape(bsz, nb, Q_BLOCK, SWA_KV_HEADS, SWA_GROUP, SWA_DH), 1, 0)
    ob_l = lax.map(lambda a: swa_block(a[0], a[1], kb_pad, vb_pad, kb_c, vb_c, sink5, n),
                   (qb_blocks, jnp.arange(nb)))
    ob_l = jnp.moveaxis(ob_l, 0, 1).reshape(bsz, n, SWA_OUT)

    def merge(oa, ob):
        bb, nn = oa.shape[:2]
        oa = (rmsnorm(oa, subln_g) * (1.0 - lam_init)).reshape(bb, nn, DIFF_OUT)
        return jnp.concatenate([oa, ob], axis=-1) @ w_out

    y_lat = merge(oa_l, ob_l)
    y_ctx = None
    if need_ctx_out:
        oa_c = diff_attend(qa_c, ka_c, va_c, lam)
        ob_c = swa_ctx(qb_c, kb_c, vb_c, sink5).reshape(bsz, n_ctx, SWA_OUT)
        y_ctx = merge(oa_c, ob_c)
    return y_lat, y_ctx


def gated_delta_rule(q, k, v, beta, g, state):
    f32 = jnp.float32
    b, n, h, dk = q.shape
    c = DN_CHUNK
    nc = n // c

    def chunks(t):
        t = t.astype(f32).reshape((b, nc, c) + t.shape[2:])
        return jnp.moveaxis(t, (1, 2), (0, 3))

    qc, kc, vc, bc, gc = (chunks(t) for t in (q, k, v, beta, g))
    gam = jnp.cumsum(gc, axis=-1)
    tril = jnp.tril(jnp.ones((c, c), dtype=bool))
    strict = jnp.tril(jnp.ones((c, c), dtype=bool), -1)
    diff = gam[..., :, None] - gam[..., None, :]
    decay = jnp.where(tril, jnp.exp(jnp.where(tril, diff, 0.0)), 0.0)
    kk = jnp.einsum('...rd,...sd->...rs', kc, kc)
    a = jnp.where(strict, bc[..., :, None] * kk * decay, 0.0)
    rhs = jnp.concatenate([kc * (bc * jnp.exp(gam))[..., None], vc * bc[..., None]], axis=-1)
    sol = lax.linalg.triangular_solve(jnp.eye(c, dtype=f32) + a, rhs, left_side=True, lower=True,
                                      unit_diagonal=True)
    w, u = sol[..., :dk], sol[..., dk:]
    aqk = jnp.where(tril, jnp.einsum('...rd,...sd->...rs', qc, kc) * decay, 0.0)
    qd = qc * jnp.exp(gam)[..., None]
    last = gam[..., -1:]
    kd = kc * jnp.exp(last - gam)[..., None]
    el = jnp.exp(last)[..., None]

    def step(s, xs):
        w_, u_, qd_, kd_, aqk_, el_ = xs
        vnew = u_ - w_ @ s
        o = qd_ @ s + aqk_ @ vnew
        s = el_ * s + jnp.swapaxes(kd_, -1, -2) @ vnew
        return s, o

    state, o = lax.scan(step, state.astype(f32), (w, u, qd, kd, aqk, el))
    o = jnp.moveaxis(o, (0, 3), (1, 2)).reshape(b, n, h, v.shape[-1])
    return o, state


def deltanet_mixer(h_lat, h_ctx, w_in, conv_w, a_log, dt_bias, onorm_g, w_out, need_ctx_out):
    rep = DN_V_HEADS // DN_QK_HEADS

    def project(h):
        bb, nn, _ = h.shape
        qkv, z, gates = _split(h @ w_in, DN_IN_SIZES)
        qkv = jax.nn.silu(dwconv_centred(qkv, conv_w))
        q, k, v = _split(qkv, (DN_QK_HEADS * DN_DK, DN_QK_HEADS * DN_DK, DN_OUT))
        q = jnp.repeat(l2norm(q.reshape(bb, nn, DN_QK_HEADS, DN_DK)), rep, axis=2) * (DN_DK ** -0.5)
        k = jnp.repeat(l2norm(k.reshape(bb, nn, DN_QK_HEADS, DN_DK)), rep, axis=2)
        v = v.reshape(bb, nn, DN_V_HEADS, DN_DV)
        gates = gates.reshape(bb, nn, 2, 2, DN_V_HEADS).astype(jnp.float32)
        beta = jax.nn.sigmoid(gates[:, :, :, 0])
        g = -jnp.exp(a_log.astype(jnp.float32)) * jax.nn.softplus(gates[:, :, :, 1] + dt_bias.astype(jnp.float32))
        return q, k, v, z, beta, g

    ql, kl, vl, zl, bl, gl = project(h_lat)
    qc, kc, vc, zc, bcx, gcx = project(h_ctx)
    bsz = h_lat.shape[0]
    zero = jnp.zeros((bsz, DN_V_HEADS, DN_DK, DN_DV), jnp.float32)
    o_lat = 0.0
    o_ctx = 0.0
    for d, rev in enumerate((False, True)):
        f = (lambda t: jnp.flip(t, axis=1)) if rev else (lambda t: t)
        oc, s_ctx = gated_delta_rule(f(qc), f(kc), f(vc), f(bcx[:, :, d]), f(gcx[:, :, d]), zero)
        ol, _ = gated_delta_rule(f(ql), f(kl), f(vl), f(bl[:, :, d]), f(gl[:, :, d]), s_ctx)
        o_lat = o_lat + f(ol)
        o_ctx = o_ctx + f(oc)

    def out(o, z):
        bb, nn = z.shape[:2]
        o = rmsnorm(o.astype(z.dtype), onorm_g) * jax.nn.silu(z.reshape(bb, nn, DN_V_HEADS, DN_DV))
        return o.reshape(bb, nn, DN_OUT) @ w_out

    y_lat = out(o_lat, zl)
    y_ctx = out(o_ctx, zc) if need_ctx_out else None
    return y_lat, y_ctx


def conv_ffn(h, w_up, conv_w, w_down):
    u = dwconv_centred(h @ w_up, conv_w)
    gate, up = jnp.split(u, 2, axis=-1)
    return (jax.nn.silu(gate) * up) @ w_down


def setup_inputs(seed: int = 0) -> dict:
    key = jax.random.key(seed)
    ks = iter(jax.random.split(key, 32))
    nrm = lambda shape, s: jax.random.normal(next(ks), shape, jnp.float32) * s
    gain = lambda shape: 1.0 + nrm(shape, 0.02)
    d = D_MODEL
    dt = jnp.exp(jax.random.uniform(next(ks), (N_ODD, 2, DN_V_HEADS), jnp.float32,
                                    minval=math.log(1e-3), maxval=math.log(1e-1)))
    return {
        'x': nrm((BATCH, SEQ, d), 1.0),
        'c': nrm((BATCH, d), 1.0),
        'ctx': nrm((BATCH, CTX_LEN, d), 1.0),
        'c_ctx': nrm((d,), 1.0),
        'w_mod': nrm((DEPTH, d, 6 * d), 0.5 * d ** -0.5),
        'b_mod': nrm((DEPTH, 6 * d), 0.01),
        'norm1_g': gain((DEPTH, d)),
        'norm2_g': gain((DEPTH, d)),
        'attn_w_in': nrm((N_EVEN, d, ATTN_IN), d ** -0.5),
        'diff_lambda': nrm((N_EVEN, 4, DIFF_DH), 0.1),
        'diff_subln_g': gain((N_EVEN, 2 * DIFF_DH)),
        'swa_sink': nrm((N_EVEN, SWA_HEADS), 0.5),
        'attn_w_out': nrm((N_EVEN, ATTN_OUT, d), ATTN_OUT ** -0.5),
        'dn_w_in': nrm((N_ODD, d, DN_IN), d ** -0.5),
        'dn_conv_w': nrm((N_ODD, SHORT_CONV_W, DN_CONV_CH), SHORT_CONV_W ** -0.5),
        'dn_a_log': jnp.log(jax.random.uniform(next(ks), (N_ODD, 2, DN_V_HEADS), jnp.float32, minval=1.0, maxval=16.0)),
        'dn_dt_bias': dt + jnp.log(-jnp.expm1(-dt)),
        'dn_norm_g': gain((N_ODD, DN_DV)),
        'dn_w_out': nrm((N_ODD, DN_OUT, d), DN_OUT ** -0.5),
        'ffn_w_up': nrm((DEPTH, d, 2 * FFN_HIDDEN), d ** -0.5),
        'ffn_conv_w': nrm((DEPTH, FFN_CONV_W, 2 * FFN_HIDDEN), FFN_CONV_W ** -0.5),
        'ffn_w_down': nrm((DEPTH, FFN_HIDDEN, d), FFN_HIDDEN ** -0.5),
        'final_norm_g': gain((d,)),
    }


def reference(x, c, ctx, c_ctx, w_mod, b_mod, norm1_g, norm2_g, attn_w_in, diff_lambda, diff_subln_g,
              swa_sink, attn_w_out, dn_w_in, dn_conv_w, dn_a_log, dn_dt_bias, dn_norm_g, dn_w_out,
              ffn_w_up, ffn_conv_w, ffn_w_down, final_norm_g):
    n = x.shape[1]
    cos, sin = axial_rope_tables(n)
    x_lat, x_ctx = x, ctx
    for layer in range(DEPTH):
        need_ctx = layer < DEPTH - 1
        mod_l = jax.nn.silu(c) @ w_mod[layer] + b_mod[layer]
        mod_c = jax.nn.silu(c_ctx)[None, :] @ w_mod[layer] + b_mod[layer]
        sh1, sc1, g1, sh2, sc2, g2 = jnp.split(mod_l, 6, axis=-1)
        csh1, csc1, cg1, csh2, csc2, cg2 = jnp.split(mod_c, 6, axis=-1)
        h_lat = modulate(rmsnorm(x_lat, norm1_g[layer]), sh1, sc1)
        h_ctx = modulate(rmsnorm(x_ctx, norm1_g[layer]), csh1, csc1)
        if layer % 2 == 0:
            i = layer // 2
            lam_init = 0.8 - 0.6 * math.exp(-0.3 * layer)
            y_lat, y_ctx = attention_mixer(h_lat, h_ctx, attn_w_in[i], diff_lambda[i], diff_subln_g[i],
                                           swa_sink[i], attn_w_out[i], lam_init, cos, sin, need_ctx)
        else:
            i = layer // 2
            y_lat, y_ctx = deltanet_mixer(h_lat, h_ctx, dn_w_in[i], dn_conv_w[i], dn_a_log[i], dn_dt_bias[i],
                                          dn_norm_g[i], dn_w_out[i], need_ctx)
        x_lat = x_lat + g1[:, None, :] * y_lat
        h_lat = modulate(rmsnorm(x_lat, norm2_g[layer]), sh2, sc2)
        x_lat = x_lat + g2[:, None, :] * conv_ffn(h_lat, ffn_w_up[layer], ffn_conv_w[layer], ffn_w_down[layer])
        if need_ctx:
            x_ctx = x_ctx + cg1[:, None, :] * y_ctx
            h_ctx = modulate(rmsnorm(x_ctx, norm2_g[layer]), csh2, csc2)
            x_ctx = x_ctx + cg2[:, None, :] * conv_ffn(h_ctx, ffn_w_up[layer], ffn_conv_w[layer], ffn_w_down[layer])
    return rmsnorm(x_lat, final_norm_g)
```

```cpp
#include <hip/hip_runtime.h>
#include <cstdio>
#include <cstdint>
#include <cmath>
namespace pg8 {
#define PG8_LAS __attribute__((address_space(3)))
typedef unsigned short bf16_t;
typedef short bf16x8 __attribute__((ext_vector_type(8)));
typedef float f32x4 __attribute__((ext_vector_type(4)));
typedef unsigned u32x4 __attribute__((ext_vector_type(4)));
constexpr int BM = 256, BK = 64, HALF = 128, HTB = HALF * BK * 2  , STAGE_BYTES = 8 * HTB, NXCD = 8, WGM = 4;

__host__ __device__ __forceinline__ int lds_byte(int r, int c) { const int st = (r >> 4) * 2 + (c >> 5), rr = r & 15, cc = c & 31, ob = rr * 64 + cc * 2; return st * 1024 + (ob ^ (((ob >> 9) & 1) << 5)); }
__host__ __device__ __forceinline__ void stage_rc(int b, int& R, int& C) { const int st = b / 1024, sb = b % 1024, swz = sb ^ (((sb >> 9) & 1) << 5); R = (st >> 1) * 16 + swz / 64; C = (st & 1) * 32 + (swz % 64) / 2; }
__host__ __device__ __forceinline__ int perm32(int rho) { const int n = rho >> 4, i = rho & 15; return 8 * (i >> 2) + 4 * n + (i & 3); }

struct Unit { int pm, pn, koff, aux; };
struct Gemm { const bf16_t* A; const bf16_t* Bt; int M, N, K, ld; };

struct StaticOrder {
    int nM, nN, nwg, G, c;
    __host__ __device__ void init(int M, int N, int G_, int c_) { nM = M / BM; nN = N / BM; nwg = nM * nN; G = G_; c = c_; }
    __host__ __device__ bool next(int i, Unit& u) const {
        const long L = (long)i * G + c; if (L >= nwg) return false;
        int wgid = (int)L; { const int q = nwg / NXCD, r = nwg % NXCD, xcd = wgid % NXCD, off = wgid / NXCD; wgid = (xcd < r ? xcd * (q + 1) : r * (q + 1) + (xcd - r) * q) + off; }
        const int nig = WGM * nN, gid = wgid / nig, fm = gid * WGM, gsz = (nM - fm) < WGM ? (nM - fm) : WGM;
        u.pm = fm + ((wgid % nig) % gsz); u.pn = (wgid % nig) / gsz; u.koff = 0; u.aux = 0; return true;
    }
    __device__ __forceinline__ void a_ready(const Unit&) const {}
    __device__ __forceinline__ void done(const Unit&) const {}
};

struct SliceOrder {
    int nN, nS, ks, G, c;
    __host__ __device__ void init(int N, int nslices, int kslice, int G_, int c_) { nN = N / BM; nS = nslices; ks = kslice; G = G_; c = c_; }
    __host__ __device__ bool next(int i, Unit& u) const { const int L = i * G + c; if (L >= nN * nS) return false; u.pm = 0; u.pn = L % nN; u.aux = L / nN; u.koff = u.aux * ks; return true; }
    __device__ __forceinline__ void a_ready(const Unit&) const {}
    __device__ __forceinline__ void done(const Unit&) const {}
};

__device__ __forceinline__ unsigned cvt_pk_bf16(float lo, float hi) { unsigned r; asm volatile("v_cvt_pk_bf16_f32 %0, %1, %2" : "=v"(r) : "v"(lo), "v"(hi)); return r; }

struct EpiBf16 {
    static constexpr bool PERM = true, AFTER_DRAIN = false;
    bf16_t* O; int ldc;
    __device__ __forceinline__ void operator()(const f32x4 (&acc)[2][2][4][2], const Unit& u, int wr, int wc, int fr, int fq) const {
        const int row0 = u.pm * BM + wr * 64 + fr, col0 = u.pn * BM + wc * 32 + 8 * fq;
#pragma unroll
        for (int ai = 0; ai < 2; ++ai)
#pragma unroll
            for (int m = 0; m < 4; ++m) { bf16_t* rowp = O + (size_t)(row0 + ai * HALF + m * 16) * ldc + col0;
#pragma unroll
                for (int bj = 0; bj < 2; ++bj) { const f32x4 v0 = acc[ai][bj][m][0], v1 = acc[ai][bj][m][1];
                    u32x4 w; w.x = cvt_pk_bf16(v0[0], v0[1]); w.y = cvt_pk_bf16(v0[2], v0[3]); w.z = cvt_pk_bf16(v1[0], v1[1]); w.w = cvt_pk_bf16(v1[2], v1[3]);
                    *(u32x4*)(rowp + bj * HALF) = w; } }
    }
};
struct EpiQKV {
    static constexpr bool PERM = true, AFTER_DRAIN = false;
    bf16_t* O; int ldc; const float* rope;
    __device__ __forceinline__ void operator()(const f32x4 (&acc)[2][2][4][2], const Unit& u, int wr, int wc, int fr, int fq) const {
        const int row0 = u.pm * BM + wr * 64 + fr, col0 = u.pn * BM + wc * 32 + 8 * fq;
        const bool do_rope = (u.pm >= 1) && (u.pn < 8 || (u.pn >= 12 && u.pn <= 16));
        const int jg = 4 * wc + fq, axis = jg >> 3, f0 = 4 * (jg & 7);
#pragma unroll
        for (int ai = 0; ai < 2; ++ai)
#pragma unroll
            for (int m = 0; m < 4; ++m) { const int row = row0 + ai * HALF + m * 16; bf16_t* rowp = O + (size_t)row * ldc + col0;
                f32x4 cs = (f32x4){1.f, 1.f, 1.f, 1.f}, sn = (f32x4){0.f, 0.f, 0.f, 0.f};
                if (do_rope) { const int t = row - 256; const int pos = axis ? (t & 63) : (t >> 6); cs = *(const f32x4*)(rope + pos * 32 + f0); sn = *(const f32x4*)(rope + 8192 + pos * 32 + f0); }
#pragma unroll
                for (int bj = 0; bj < 2; ++bj) { const f32x4 x1 = acc[ai][bj][m][0], x2 = acc[ai][bj][m][1];
                    const f32x4 v0 = x1 * cs - x2 * sn, v1 = x2 * cs + x1 * sn;
                    u32x4 w; w.x = cvt_pk_bf16(v0[0], v0[1]); w.y = cvt_pk_bf16(v0[2], v0[3]); w.z = cvt_pk_bf16(v1[0], v1[1]); w.w = cvt_pk_bf16(v1[2], v1[3]);
                    *(u32x4*)(rowp + bj * HALF) = w; } }
    }
};
struct EpiDnIn {
    static constexpr bool PERM = true, AFTER_DRAIN = false;
    bf16_t* RAW; bf16_t* Z; float* GATES;
    __device__ __forceinline__ void operator()(const f32x4 (&acc)[2][2][4][2], const Unit& u, int wr, int wc, int fr, int fq) const {
        const int row0 = u.pm * BM + wr * 64 + fr;
        if (u.pn < 48) {
            bf16_t* base; int ldc, colt;
            if (u.pn < 32) { base = RAW; ldc = 8192; colt = u.pn * BM; } else { base = Z; ldc = 4096; colt = (u.pn - 32) * BM; }
            const int col0 = colt + wc * 32 + 8 * fq;
#pragma unroll
            for (int ai = 0; ai < 2; ++ai)
#pragma unroll
                for (int m = 0; m < 4; ++m) { bf16_t* rowp = base + (size_t)(row0 + ai * HALF + m * 16) * ldc + col0;
#pragma unroll
                    for (int bj = 0; bj < 2; ++bj) { const f32x4 v0 = acc[ai][bj][m][0], v1 = acc[ai][bj][m][1];
                        u32x4 w; w.x = cvt_pk_bf16(v0[0], v0[1]); w.y = cvt_pk_bf16(v0[2], v0[3]); w.z = cvt_pk_bf16(v1[0], v1[1]); w.w = cvt_pk_bf16(v1[2], v1[3]);
                        *(u32x4*)(rowp + bj * HALF) = w; } }
        } else {
            const int col0 = wc * 32 + 8 * fq;
#pragma unroll
            for (int ai = 0; ai < 2; ++ai)
#pragma unroll
                for (int m = 0; m < 4; ++m) { float* rowp = GATES + (size_t)(row0 + ai * HALF + m * 16) * 128 + col0;
                    *(f32x4*)(rowp) = acc[ai][0][m][0]; *(f32x4*)(rowp + 4) = acc[ai][0][m][1]; }
        }
    }
};
struct EpiResid {
    static constexpr bool PERM = false, AFTER_DRAIN = false;
    float* X; int ldc; const float* gate_lat; const float* gate_ctx;
    __device__ __forceinline__ void operator()(const f32x4 (&acc)[2][2][4][2], const Unit& u, int wr, int wc, int fr, int fq) const {
        const int row0 = u.pm * BM + wr * 64 + fr, col0 = u.pn * BM + wc * 32 + 4 * fq;
        const float* gate = (u.pm == 0) ? gate_ctx : gate_lat;
        f32x4 gv[2][2];
#pragma unroll
        for (int bj = 0; bj < 2; ++bj)
#pragma unroll
            for (int n = 0; n < 2; ++n) gv[bj][n] = *(const f32x4*)(gate + col0 + bj * HALF + n * 16);
        f32x4 xa[4], xb[4];
#define ER_ROW(g) (X + (size_t)(row0 + ((g) >> 2) * HALF + ((g) & 3) * 16) * ldc + col0)
#define ER_LD(xv, g) do { const float* rp_ = ER_ROW(g); _Pragma("unroll") for (int q = 0; q < 4; ++q) xv[q] = *(const f32x4*)(rp_ + (q >> 1) * HALF + (q & 1) * 16); } while (0)
#define ER_ST(xv, g) do { float* rp_ = ER_ROW(g); _Pragma("unroll") for (int q = 0; q < 4; ++q) *(f32x4*)(rp_ + (q >> 1) * HALF + (q & 1) * 16) = xv[q] + gv[q >> 1][q & 1] * acc[(g) >> 2][q >> 1][(g) & 3][q & 1]; } while (0)
        ER_LD(xa, 0);
#pragma unroll
        for (int g = 0; g < 8; g += 2) {
            ER_LD(xb, g + 1); asm volatile("" ::: "memory");
            ER_ST(xa, g); asm volatile("" ::: "memory");
            if (g + 2 < 8) ER_LD(xa, g + 2);
            asm volatile("" ::: "memory");
            ER_ST(xb, g + 1); asm volatile("" ::: "memory");
        }
#undef ER_ROW
#undef ER_LD
#undef ER_ST
    }
};

struct EpiPart {
    static constexpr bool PERM = false, AFTER_DRAIN = false;
    float* P; int ldc;
    __device__ __forceinline__ void operator()(const f32x4 (&acc)[2][2][4][2], const Unit& u, int wr, int wc, int fr, int fq) const {
        const int row0 = wr * 64 + fr, col0 = u.pn * BM + wc * 32 + 4 * fq; float* base = P + (size_t)u.aux * BM * ldc;
#pragma unroll
        for (int ai = 0; ai < 2; ++ai)
#pragma unroll
            for (int m = 0; m < 4; ++m) { float* rowp = base + (size_t)(row0 + ai * HALF + m * 16) * ldc + col0;
#pragma unroll
                for (int bj = 0; bj < 2; ++bj)
#pragma unroll
                    for (int n = 0; n < 2; ++n) *(f32x4*)(rowp + bj * HALF + n * 16) = acc[ai][bj][m][n]; }
    }
};
template <class Epi, class Sched, bool ALIGN_EPI = false, bool SP2 = false>
__device__ __forceinline__ void gemm_phase(PG8_LAS unsigned char* lds, const Gemm g, const Sched& S, const Epi& E, int tid_in) {
    const int tid = tid_in, wid = __builtin_amdgcn_readfirstlane(tid >> 6), lane = tid & 63, wr = wid >> 2, wc = wid & 3, fr = lane & 15, fq = lane >> 4;
    const int K = g.ld, nt = g.K / BK;
    unsigned voffA[2], voffB[2];
#pragma unroll
    for (int i = 0; i < 2; ++i) { int R, C; stage_rc(tid * 16 + i * 8192, R, C); const int Rb = Epi::PERM ? ((R & ~31) + perm32(R & 31)) : R;
        voffA[i] = (unsigned)(R * K + C) * 2u; voffB[i] = (unsigned)(Rb * K + C) * 2u; }
    const size_t kstep = (size_t)(BK * 2);
    const size_t hstep = (size_t)HALF * K * 2;
    const size_t tstep = 2 * hstep;
    const unsigned ldsw = (unsigned)wid * 1024u;
    const int aoff = lds_byte(wr * 64 + fr, fq * 8), boff = lds_byte(wc * 32 + fr, fq * 8);
#define PG8_SA(b, h) (((b) * 2 + (h)) * HTB)
#define PG8_SB(b, h) ((4 + (b) * 2 + (h)) * HTB)
#define PG8_STAGE(bufoff, gbase, voff) do { _Pragma("unroll") for (int _i = 0; _i < 2; ++_i) \
        __builtin_amdgcn_global_load_lds((const unsigned*)((const char*)(gbase) + (voff)[_i]), (PG8_LAS unsigned*)(lds + (bufoff) + ldsw + _i * 8192), 16, 0, 0); } while (0)
#define PG8_LDA(dst, b, h) do { _Pragma("unroll") for (int m = 0; m < 4; ++m) _Pragma("unroll") for (int k = 0; k < 2; ++k) dst[m][k] = *(const PG8_LAS bf16x8*)(lds + PG8_SA(b, h) + aoff + m * 2048 + k * 1024); } while (0)
#define PG8_LDB(dst, b, h) do { _Pragma("unroll") for (int n = 0; n < 2; ++n) _Pragma("unroll") for (int k = 0; k < 2; ++k) dst[n][k] = *(const PG8_LAS bf16x8*)(lds + PG8_SB(b, h) + boff + n * 2048 + k * 1024); } while (0)
#define PG8_MMA(ai, bj, At, Bt) do { __builtin_amdgcn_s_setprio(1); _Pragma("unroll") for (int m = 0; m < 4; ++m) _Pragma("unroll") for (int n = 0; n < 2; ++n) _Pragma("unroll") for (int k = 0; k < 2; ++k) \
        acc[ai][bj][m][n] = __builtin_amdgcn_mfma_f32_16x16x32_bf16(Bt[n][k], At[m][k], acc[ai][bj][m][n], 0, 0, 0); __builtin_amdgcn_s_setprio(0); } while (0)
#define PG8_WAIT_V(n) asm volatile("s_waitcnt vmcnt(" #n ")" ::: "memory")
#define PG8_WAIT_L(n) asm volatile("s_waitcnt lgkmcnt(" #n ")" ::: "memory")
#define PG8_BAR __builtin_amdgcn_s_barrier()
#define PG8_SCHED __builtin_amdgcn_sched_barrier(0)
    Unit cur, nxt; int ui = 0;
    if (!S.next(0, cur)) return;
    f32x4 acc[2][2][4][2];
#pragma unroll
    for (int a = 0; a < 2; ++a)
#pragma unroll
        for (int b = 0; b < 2; ++b)
#pragma unroll
            for (int m = 0; m < 4; ++m)
#pragma unroll
                for (int n = 0; n < 2; ++n) acc[a][b][m][n] = (f32x4){0.f, 0.f, 0.f, 0.f};
    bf16x8 At[4][2], B0[2][2], B1[2][2];
    const char* cA = (const char*)g.A + (size_t)cur.pm * tstep + (size_t)cur.koff * 2; const char* cB = (const char*)g.Bt + (size_t)cur.pn * tstep + (size_t)cur.koff * 2;
    S.a_ready(cur);
    if constexpr (SP2) {
        PG8_STAGE(PG8_SB(0, 0), cB, voffB); PG8_STAGE(PG8_SB(0, 1), cB + hstep, voffB); PG8_STAGE(PG8_SA(0, 0), cA, voffA); PG8_STAGE(PG8_SA(0, 1), cA + hstep, voffA);
        if (wr == 1) PG8_BAR;
        PG8_WAIT_V(2); PG8_BAR;
        PG8_STAGE(PG8_SB(1, 0), cB + kstep, voffB); PG8_STAGE(PG8_SA(1, 0), cA + kstep, voffA); PG8_STAGE(PG8_SB(1, 1), cB + hstep + kstep, voffB);
        PG8_WAIT_V(6); PG8_BAR;
    } else {
        PG8_STAGE(PG8_SB(0, 0), cB, voffB); PG8_STAGE(PG8_SA(0, 0), cA, voffA); PG8_STAGE(PG8_SB(0, 1), cB + hstep, voffB); PG8_STAGE(PG8_SA(0, 1), cA + hstep, voffA);
        if (wr == 1) PG8_BAR;
        PG8_WAIT_V(4); PG8_BAR;
        PG8_STAGE(PG8_SB(1, 0), cB + kstep, voffB); PG8_STAGE(PG8_SA(1, 0), cA + kstep, voffA); PG8_STAGE(PG8_SB(1, 1), cB + hstep + kstep, voffB);
        PG8_WAIT_V(6); PG8_BAR;
    }
    for (;;) {
        const bool has_next = S.next(ui + 1, nxt);
        const char* nA = has_next ? (const char*)g.A + (size_t)nxt.pm * tstep + (size_t)nxt.koff * 2 : cA; const char* nB = has_next ? (const char*)g.Bt + (size_t)nxt.pn * tstep + (size_t)nxt.koff * 2 : cB;
        for (int t = 0; t < nt; t += 2) {
            const bool last = (t == nt - 2);
            const char* a1 = cA + (size_t)(t + 1) * kstep;
            const char* a2 = last ? nA : cA + (size_t)(t + 2) * kstep; const char* b2 = last ? nB : cB + (size_t)(t + 2) * kstep;
            const char* a3 = a2 + kstep; const char* b3 = b2 + kstep;
            if (last && has_next) S.a_ready(nxt);
            if constexpr (SP2) {
            PG8_LDB(B0, 0, 0); PG8_LDB(B1, 0, 1); PG8_SCHED; PG8_LDA(At, 0, 0); PG8_STAGE(PG8_SA(1, 1), a1 + hstep, voffA);
            PG8_WAIT_V(8); PG8_WAIT_L(0); PG8_BAR; PG8_MMA(0, 0, At, B0); PG8_MMA(0, 1, At, B1); PG8_BAR; PG8_SCHED;
            PG8_LDA(At, 0, 1); PG8_STAGE(PG8_SB(0, 0), b2, voffB); PG8_STAGE(PG8_SB(0, 1), b2 + hstep, voffB); PG8_STAGE(PG8_SA(0, 0), a2, voffA);
            PG8_WAIT_V(8); PG8_WAIT_L(0); PG8_BAR; PG8_MMA(1, 0, At, B0); PG8_MMA(1, 1, At, B1); PG8_BAR; PG8_SCHED;
            PG8_LDB(B0, 1, 0); PG8_LDB(B1, 1, 1); PG8_SCHED; PG8_LDA(At, 1, 0); PG8_STAGE(PG8_SA(0, 1), a2 + hstep, voffA);
            PG8_WAIT_V(8); PG8_WAIT_L(0); PG8_BAR; PG8_MMA(0, 0, At, B0); PG8_MMA(0, 1, At, B1); PG8_BAR; PG8_SCHED;
            PG8_LDA(At, 1, 1); PG8_STAGE(PG8_SB(1, 0), b3, voffB); PG8_STAGE(PG8_SB(1, 1), b3 + hstep, voffB); PG8_STAGE(PG8_SA(1, 0), a3, voffA);
            PG8_WAIT_V(8); PG8_WAIT_L(0); PG8_BAR; PG8_MMA(1, 0, At, B0); PG8_MMA(1, 1, At, B1); PG8_BAR; PG8_SCHED;
            } else {
            PG8_LDB(B0, 0, 0); PG8_SCHED; PG8_LDA(At, 0, 0); PG8_STAGE(PG8_SA(1, 1), a1 + hstep, voffA);
            PG8_WAIT_L(8); PG8_BAR; PG8_WAIT_L(0); PG8_MMA(0, 0, At, B0); PG8_BAR; PG8_SCHED;
            PG8_LDB(B1, 0, 1); PG8_STAGE(PG8_SB(0, 0), b2, voffB);
            PG8_BAR; PG8_WAIT_L(0); PG8_MMA(0, 1, At, B1); PG8_BAR;
            PG8_LDA(At, 0, 1); PG8_STAGE(PG8_SA(0, 0), a2, voffA);
            PG8_BAR; PG8_WAIT_L(0); PG8_MMA(1, 0, At, B0); PG8_BAR; PG8_SCHED;
            PG8_STAGE(PG8_SB(0, 1), b2 + hstep, voffB);
            PG8_WAIT_V(6); PG8_BAR; PG8_MMA(1, 1, At, B1); PG8_BAR;
            PG8_LDB(B0, 1, 0); PG8_SCHED; PG8_LDA(At, 1, 0); PG8_STAGE(PG8_SA(0, 1), a2 + hstep, voffA);
            PG8_WAIT_L(8); PG8_BAR; PG8_WAIT_L(0); PG8_MMA(0, 0, At, B0); PG8_BAR; PG8_SCHED;
            PG8_LDB(B1, 1, 1); PG8_STAGE(PG8_SB(1, 0), b3, voffB);
            PG8_BAR; PG8_WAIT_L(0); PG8_MMA(0, 1, At, B1); PG8_BAR;
            PG8_LDA(At, 1, 1); PG8_STAGE(PG8_SA(1, 0), a3, voffA);
            PG8_BAR; PG8_WAIT_L(0); PG8_MMA(1, 0, At, B0); PG8_BAR; PG8_SCHED;
            PG8_STAGE(PG8_SB(1, 1), b3 + hstep, voffB);
            PG8_WAIT_V(6); PG8_BAR; PG8_MMA(1, 1, At, B1); PG8_BAR;
            }
        }
        if constexpr (ALIGN_EPI) { if (wr == 0) PG8_BAR; }
        if constexpr (!Epi::AFTER_DRAIN) { E(acc, cur, wr, wc, fr, fq); S.done(cur); }
        if (!has_next) break;
#pragma unroll
        for (int a = 0; a < 2; ++a)
#pragma unroll
            for (int b = 0; b < 2; ++b)
#pragma unroll
                for (int m = 0; m < 4; ++m)
#pragma unroll
                    for (int n = 0; n < 2; ++n) acc[a][b][m][n] = (f32x4){0.f, 0.f, 0.f, 0.f};
        cur = nxt; cA = nA; cB = nB; ++ui;
        if constexpr (ALIGN_EPI) { if (wr == 1) PG8_BAR; }
    }
    PG8_WAIT_V(0);
    if constexpr (!ALIGN_EPI) { if (wr == 0) PG8_BAR; }
    PG8_BAR;
    if constexpr (Epi::AFTER_DRAIN) { E.fused(acc, cur, wr, wc, fr, fq, lds, wid, lane); S.done(cur); }
#undef PG8_SA
#undef PG8_SB
#undef PG8_STAGE
#undef PG8_LDA
#undef PG8_LDB
#undef PG8_MMA
#undef PG8_WAIT_V
#undef PG8_WAIT_L
#undef PG8_BAR
#undef PG8_SCHED
}
}

namespace att {
using bf16x8 = __attribute__((ext_vector_type(8))) short;
using s16x4  = __attribute__((ext_vector_type(4))) short;
using f32x16 = __attribute__((ext_vector_type(16))) float;
using u32x4  = __attribute__((ext_vector_type(4))) unsigned;
typedef unsigned short bf16;
constexpr int   D = 128, NW = 8, QBLK = 32, KVBLK = 64;
constexpr float SCALE = 0.088388347648318440f;
constexpr float THR = 8.f;
constexpr size_t SHM_V = KVBLK * D * 2, SHM_K = KVBLK * D * 2, SHM_ATTN = 2 * SHM_V + 2 * SHM_K + NW * 64 * 4;
#define KSWZ(row, colB) ((row) * 256 + ((colB) ^ (((row) & 7) << 4)))
#define SBAR() __builtin_amdgcn_sched_barrier(0)
__device__ __forceinline__ int crow(int r, int hi) { return (r & 3) + 8 * (r >> 2) + 4 * hi; }
__device__ __forceinline__ unsigned cvtpk(float lo, float hi) { unsigned r; asm volatile("v_cvt_pk_bf16_f32 %0, %1, %2" : "=v"(r) : "v"(lo), "v"(hi)); return r; }

__device__ __forceinline__ void partialSM(f32x16& p0, f32x16& p1, float& m_reg, float& mn, float& alpha) {
  constexpr float C = SCALE * 1.4426950408889634f;
  float pmax = p0[0]; for (int r = 1; r < 16; ++r) pmax = fmaxf(pmax, p0[r]); for (int r = 0; r < 16; ++r) pmax = fmaxf(pmax, p1[r]);
  { auto rr = __builtin_amdgcn_permlane32_swap(__float_as_uint(pmax), __float_as_uint(pmax), false, false);
    pmax = fmaxf(__uint_as_float(rr[0]), __uint_as_float(rr[1])); }
  if (__builtin_expect(__all(pmax - m_reg <= THR / SCALE), 1)) { mn = m_reg; alpha = 1.f; }
  else { mn = fmaxf(m_reg, pmax); alpha = __builtin_amdgcn_exp2f((m_reg - mn) * C); m_reg = mn; }
  float mnC = -mn * C;
  for (int r = 0; r < 16; ++r) p0[r] = fmaf(p0[r], C, mnC); for (int r = 0; r < 16; ++r) p1[r] = fmaf(p1[r], C, mnC);
  for (int r = 0; r < 16; ++r) p0[r] = __builtin_amdgcn_exp2f(p0[r]);
}
__device__ __forceinline__ void finishSM(f32x16& p0, f32x16& p1, float alpha, float& l_reg, bf16x8& pa0, bf16x8& pa1, bf16x8& pa2, bf16x8& pa3) {
  for (int r = 0; r < 16; ++r) p1[r] = __builtin_amdgcn_exp2f(p1[r]);
  float ps = 0; for (int r = 0; r < 16; ++r) ps += p0[r]; for (int r = 0; r < 16; ++r) ps += p1[r];
  { auto rr = __builtin_amdgcn_permlane32_swap(__float_as_uint(ps), __float_as_uint(ps), false, false);
    ps = __uint_as_float(rr[0]) + __uint_as_float(rr[1]); }
  l_reg = l_reg * alpha + ps;
#define PK4(P, BASE, OUT) do { unsigned a0 = cvtpk(P[BASE + 0], P[BASE + 1]), a1 = cvtpk(P[BASE + 2], P[BASE + 3]);   \
    unsigned b0 = cvtpk(P[BASE + 4], P[BASE + 5]), b1 = cvtpk(P[BASE + 6], P[BASE + 7]);                              \
    auto r0 = __builtin_amdgcn_permlane32_swap(a0, b0, false, false); auto r1 = __builtin_amdgcn_permlane32_swap(a1, b1, false, false); \
    u32x4 w = {r0[0], r1[0], r0[1], r1[1]}; OUT = *reinterpret_cast<bf16x8*>(&w); } while (0)
  PK4(p0, 0, pa0); PK4(p0, 8, pa1); PK4(p1, 0, pa2); PK4(p1, 8, pa3);
#undef PK4
}
__device__ __forceinline__ void qkt(f32x16& p0, f32x16& p1, const bf16* Ks, const bf16x8* qr, int r32, int hi) {
  p0 = f32x16{}; p1 = f32x16{};
  for (int d0 = 0; d0 < 8; ++d0) { int cb = (d0 * 16 + hi * 8) * 2;
    bf16x8 b0 = *reinterpret_cast<const bf16x8*>((const char*)Ks + KSWZ(r32, cb));
    bf16x8 b1 = *reinterpret_cast<const bf16x8*>((const char*)Ks + KSWZ(32 + r32, cb));
    p0 = __builtin_amdgcn_mfma_f32_32x32x16_bf16(b0, qr[d0], p0, 0, 0, 0);
    p1 = __builtin_amdgcn_mfma_f32_32x32x16_bf16(b1, qr[d0], p1, 0, 0, 0); }
}
__device__ __forceinline__ void wmask(f32x16& p0, f32x16& p1, int dq  , int hi) {
#pragma unroll
  for (int r = 0; r < 16; ++r) { const int d0 = dq - crow(r, hi), d1 = d0 - 32;
    p0[r] = (d0 <= 128 && d0 >= -128) ? p0[r] : -1e30f; p1[r] = (d1 <= 128 && d1 >= -128) ? p1[r] : -1e30f; }
}
__device__ __forceinline__ int v_st(int k, int c) { const int kk = (k & ~0xC) | ((k & 4) << 1) | ((k & 8) >> 1); return ((kk >> 3) * 4 + (c >> 5)) * 512 + ((kk & 7) * 32 + (c & 31)) * 2; }
__device__ __forceinline__ int v_rd_base(int lane) { return ((lane & 3) << 3) | (((lane >> 2) & 3) << 6) | (((lane >> 4) & 1) << 5) | (((lane >> 5) & 1) << 8); }
constexpr int v_rd_off(int d0, int ks, int half) { return d0 * 512 + ks * 4096 + half * 2048; }
template <int OFF> __device__ __forceinline__ s16x4 tr_read(int vb) {
  s16x4 r; asm volatile("ds_read_b64_tr_b16 %0, %1 offset:%2" : "=&v"(r) : "v"(vb), "i"(OFF) : "memory"); return r;
}
template <int D0> __device__ __forceinline__ void pv_one(f32x16& od, int vb, bf16x8 pa0, bf16x8 pa1, bf16x8 pa2, bf16x8 pa3) {
  const s16x4 l0 = tr_read<v_rd_off(D0, 0, 0)>(vb), h0 = tr_read<v_rd_off(D0, 0, 1)>(vb), l1 = tr_read<v_rd_off(D0, 1, 0)>(vb), h1 = tr_read<v_rd_off(D0, 1, 1)>(vb);
  const s16x4 l2 = tr_read<v_rd_off(D0, 2, 0)>(vb), h2 = tr_read<v_rd_off(D0, 2, 1)>(vb), l3 = tr_read<v_rd_off(D0, 3, 0)>(vb), h3 = tr_read<v_rd_off(D0, 3, 1)>(vb);
  asm volatile("s_waitcnt lgkmcnt(0)" ::: "memory"); SBAR();
#define PK(L, H) (bf16x8){L[0], L[1], L[2], L[3], H[0], H[1], H[2], H[3]}
  od = __builtin_amdgcn_mfma_f32_32x32x16_bf16(pa0, PK(l0, h0), od, 0, 0, 0);
  od = __builtin_amdgcn_mfma_f32_32x32x16_bf16(pa1, PK(l1, h1), od, 0, 0, 0);
  od = __builtin_amdgcn_mfma_f32_32x32x16_bf16(pa2, PK(l2, h2), od, 0, 0, 0);
  od = __builtin_amdgcn_mfma_f32_32x32x16_bf16(pa3, PK(l3, h3), od, 0, 0, 0);
#undef PK
}
__device__ __forceinline__ void pv_d0(f32x16* o, int vb, bf16x8 pa0, bf16x8 pa1, bf16x8 pa2, bf16x8 pa3) {
  pv_one<0>(o[0], vb, pa0, pa1, pa2, pa3); pv_one<1>(o[1], vb, pa0, pa1, pa2, pa3); pv_one<2>(o[2], vb, pa0, pa1, pa2, pa3); pv_one<3>(o[3], vb, pa0, pa1, pa2, pa3);
}
template <bool MASKED, int LDQ, int LDK, int LDO, int SD>
__device__ __forceinline__ void attn_body(const bf16* __restrict__ Qb, const bf16* __restrict__ Kh, const bf16* __restrict__ Vh,
                                          float* __restrict__ Ob, int NT, int wb, int q0, float sinkl2, char* lds, int tid_in) {
  int tid_l = tid_in; asm volatile("" : "+v"(tid_l)); const int tid = tid_l, wid = tid >> 6, lane = tid & 63, r32 = lane & 31, hi = lane >> 5;
  if (wid < 4) __builtin_amdgcn_s_setprio(1); else __builtin_amdgcn_s_setprio(0);
  bf16* V_lds = (bf16*)lds; bf16* K_lds = (bf16*)(lds + 2 * SHM_V);
  float* ws = (float*)(lds + 2 * SHM_V + 2 * SHM_K) + wid * 64; float* li_l = ws; float* al_l = ws + 32;
  float m_reg = -1e30f, l_reg = 0; f32x16 o[4] = {}; bf16x8 qr[8];
  const bf16* Qw = Qb + (long)(wid * QBLK + r32) * LDQ + hi * 8;
#pragma unroll
  for (int d0 = 0; d0 < 8; ++d0) qr[d0] = *reinterpret_cast<const bf16x8*>(Qw + d0 * 16);
  const int sr = tid >> 4, sc = (tid & 15) * 8, vst0 = v_st(sr, sc), vst1 = v_st(32 + sr, sc);
  const int vb0 = (int)(uintptr_t)V_lds + v_rd_base(lane);
  const int qpos = q0 + wid * QBLK + r32;
  struct { bf16x8 vs0, vs1, ks0, ks1; } sr_[SD];
#define KB(j) (MASKED ? ((j) < 4 ? (j) * KVBLK : wb + ((j) - 4) * KVBLK) : (j) * KVBLK)
#define SLOAD(i, k0) do { sr_[i].vs0 = *reinterpret_cast<const bf16x8*>(&Vh[(long)((k0) + sr) * LDK + sc]); sr_[i].vs1 = *reinterpret_cast<const bf16x8*>(&Vh[(long)((k0) + 32 + sr) * LDK + sc]); \
    sr_[i].ks0 = *reinterpret_cast<const bf16x8*>(&Kh[(long)((k0) + sr) * LDK + sc]); sr_[i].ks1 = *reinterpret_cast<const bf16x8*>(&Kh[(long)((k0) + 32 + sr) * LDK + sc]); } while (0)
#define SWRITE(b, i) do { *(bf16x8*)((char*)V_lds + (b) * SHM_V + vst0) = sr_[i].vs0;          \
    *(bf16x8*)((char*)V_lds + (b) * SHM_V + vst1) = sr_[i].vs1; int kc = sc * 2;               \
    *(bf16x8*)((char*)K_lds + (b) * SHM_K + KSWZ(sr, kc)) = sr_[i].ks0;                       \
    *(bf16x8*)((char*)K_lds + (b) * SHM_K + KSWZ(32 + sr, kc)) = sr_[i].ks1; } while (0)
#define SWAIT() do { if (SD == 2) asm volatile("s_waitcnt vmcnt(4)" ::: "memory"); else asm volatile("s_waitcnt vmcnt(0)" ::: "memory"); } while (0)
#define RESC(a) do { if (__any((a) < 1.f)) { if (hi == 0) al_l[r32] = (a); asm volatile("s_waitcnt lgkmcnt(0)" ::: "memory"); \
    for (int d = 0; d < 4; ++d) for (int r = 0; r < 16; ++r) o[d][r] *= al_l[crow(r, hi)]; } } while (0)
#define MASK(P0, P1, j) do { if (MASKED) { if ((j) >= 4) wmask(P0, P1, qpos - (KB(j) - 256), hi); } } while (0)
  f32x16 pA0, pA1, pB0, pB1; float mnA, mnB, alA, alB; bf16x8 pa0, pa1, pa2, pa3;
  constexpr int SE = 0, SO = SD - 1;
  SLOAD(SE, KB(0)); asm volatile("s_waitcnt vmcnt(0)" ::: "memory"); SWRITE(0, SE); __syncthreads();
  qkt(pA0, pA1, K_lds, qr, r32, hi); partialSM(pA0, pA1, m_reg, mnA, alA);
  SLOAD(SO, KB(1)); if (SD == 2) { if (2 < NT) SLOAD(SE, KB(2)); }
  SWAIT(); SWRITE(1, SO); __syncthreads();
  for (int j = 1; j + 1 < NT; j += 2) {
    SBAR(); qkt(pB0, pB1, (bf16*)((char*)K_lds + SHM_K), qr, r32, hi); MASK(pB0, pB1, j);
    finishSM(pA0, pA1, alA, l_reg, pa0, pa1, pa2, pa3); SBAR();
    SLOAD(SO, KB(j + SD)); SBAR();
    pv_d0(o, vb0, pa0, pa1, pa2, pa3); partialSM(pB0, pB1, m_reg, mnB, alB);
    __syncthreads(); SWAIT(); SWRITE(0, SE);
    RESC(alB); __syncthreads();
    SBAR(); qkt(pA0, pA1, K_lds, qr, r32, hi); MASK(pA0, pA1, j + 1);
    finishSM(pB0, pB1, alB, l_reg, pa0, pa1, pa2, pa3); SBAR();
    if (SD == 1 || j + 3 < NT) SLOAD(SE, KB(j + 1 + SD)); SBAR();
    pv_d0(o, vb0 + (int)SHM_V, pa0, pa1, pa2, pa3); partialSM(pA0, pA1, m_reg, mnA, alA);
    __syncthreads(); SWAIT(); SWRITE(1, SO);
    RESC(alA); __syncthreads();
  }
  SBAR(); qkt(pB0, pB1, (bf16*)((char*)K_lds + SHM_K), qr, r32, hi); MASK(pB0, pB1, NT - 1);
  finishSM(pA0, pA1, alA, l_reg, pa0, pa1, pa2, pa3); SBAR();
  pv_d0(o, vb0, pa0, pa1, pa2, pa3); partialSM(pB0, pB1, m_reg, mnB, alB);
  __syncthreads(); RESC(alB);
  finishSM(pB0, pB1, alB, l_reg, pa0, pa1, pa2, pa3); SBAR();
  pv_d0(o, vb0 + (int)SHM_V, pa0, pa1, pa2, pa3);
  l_reg += __builtin_amdgcn_exp2f(sinkl2 - m_reg * (SCALE * 1.4426950408889634f));
  if (hi == 0) li_l[r32] = l_reg; asm volatile("s_waitcnt lgkmcnt(0)" ::: "memory");
  float rli[16];
#pragma unroll
  for (int r = 0; r < 16; ++r) rli[r] = __builtin_amdgcn_rcpf(li_l[crow(r, hi)]);
  __builtin_amdgcn_s_setprio(0);
  float* Ow = Ob + (long)(wid * QBLK) * LDO;
#pragma unroll
  for (int r = 0; r < 16; ++r) { int orow = crow(r, hi);
    for (int d0 = 0; d0 < 4; ++d0) Ow[(long)orow * LDO + d0 * 32 + r32] = o[d0][r] * rli[r]; }
  __syncthreads();
#undef KB
#undef SLOAD
#undef SWRITE
#undef SWAIT
#undef RESC
#undef MASK
}

__device__ __forceinline__ void qkt_batched(f32x16& p0, f32x16& p1, const bf16* Ks, const bf16x8* qr, int r32, int hi) {
  p0 = f32x16{}; p1 = f32x16{};
  bf16x8 k0[4], k1[4], k2[4];
#define KRD(kb, D) do { _Pragma("unroll") for (int d = 0; d < 2; ++d) { const int cb = (((D) + d) * 16 + hi * 8) * 2; \
    kb[2 * d] = *reinterpret_cast<const bf16x8*>((const char*)Ks + KSWZ(r32, cb)); kb[2 * d + 1] = *reinterpret_cast<const bf16x8*>((const char*)Ks + KSWZ(32 + r32, cb)); } } while (0)
#define KMM(kb, D) do { _Pragma("unroll") for (int d = 0; d < 2; ++d) { p0 = __builtin_amdgcn_mfma_f32_32x32x16_bf16(kb[2 * d], qr[(D) + d], p0, 0, 0, 0); p1 = __builtin_amdgcn_mfma_f32_32x32x16_bf16(kb[2 * d + 1], qr[(D) + d], p1, 0, 0, 0); } } while (0)
  KRD(k0, 0); SBAR(); KRD(k1, 2); SBAR();
  asm volatile("s_waitcnt lgkmcnt(4)" ::: "memory"); SBAR();
  KRD(k2, 4); SBAR(); KMM(k0, 0); SBAR();
  asm volatile("s_waitcnt lgkmcnt(4)" ::: "memory"); SBAR();
  KRD(k0, 6); SBAR(); KMM(k1, 2); SBAR();
  asm volatile("s_waitcnt lgkmcnt(4)" ::: "memory"); SBAR();
  KMM(k2, 4); SBAR();
  asm volatile("s_waitcnt lgkmcnt(0)" ::: "memory"); SBAR();
  KMM(k0, 6); SBAR();
#undef KRD
#undef KMM
}
__device__ __forceinline__ void pv_batched(f32x16* o, int vb, bf16x8 pa0, bf16x8 pa1, bf16x8 pa2, bf16x8 pa3) {
  s16x4 L0[4], H0[4], L1[4], H1[4];
#define TRD(Lb, Hb, D0) Lb[0] = tr_read<v_rd_off(D0, 0, 0)>(vb); Hb[0] = tr_read<v_rd_off(D0, 0, 1)>(vb); Lb[1] = tr_read<v_rd_off(D0, 1, 0)>(vb); Hb[1] = tr_read<v_rd_off(D0, 1, 1)>(vb); \
    Lb[2] = tr_read<v_rd_off(D0, 2, 0)>(vb); Hb[2] = tr_read<v_rd_off(D0, 2, 1)>(vb); Lb[3] = tr_read<v_rd_off(D0, 3, 0)>(vb); Hb[3] = tr_read<v_rd_off(D0, 3, 1)>(vb);
#define PK(Lv, Hv) (bf16x8){Lv[0], Lv[1], Lv[2], Lv[3], Hv[0], Hv[1], Hv[2], Hv[3]}
#define MM(D0, Lb, Hb) o[D0] = __builtin_amdgcn_mfma_f32_32x32x16_bf16(pa0, PK(Lb[0], Hb[0]), o[D0], 0, 0, 0); o[D0] = __builtin_amdgcn_mfma_f32_32x32x16_bf16(pa1, PK(Lb[1], Hb[1]), o[D0], 0, 0, 0); \
    o[D0] = __builtin_amdgcn_mfma_f32_32x32x16_bf16(pa2, PK(Lb[2], Hb[2]), o[D0], 0, 0, 0); o[D0] = __builtin_amdgcn_mfma_f32_32x32x16_bf16(pa3, PK(Lb[3], Hb[3]), o[D0], 0, 0, 0);
  TRD(L0, H0, 0) SBAR(); TRD(L1, H1, 1) SBAR();
  asm volatile("s_waitcnt lgkmcnt(8)" ::: "memory"); SBAR();
  MM(0, L0, H0) SBAR();
  TRD(L0, H0, 2) SBAR();
  asm volatile("s_waitcnt lgkmcnt(8)" ::: "memory"); SBAR();
  MM(1, L1, H1) SBAR();
  TRD(L1, H1, 3) SBAR();
  asm volatile("s_waitcnt lgkmcnt(8)" ::: "memory"); SBAR();
  MM(2, L0, H0) SBAR();
  asm volatile("s_waitcnt lgkmcnt(0)" ::: "memory"); SBAR();
  MM(3, L1, H1) SBAR();
#undef TRD
#undef PK
#undef MM
}
constexpr int AP_V = 0, AP_K = 65536, AP_P = 98304, AP_AL = 131072, AP_M = 132096, AP_FL = 132608, AP_LX = 132672, AP_END = 133696;
template <int LDQ, int LDK, int LDO>
__device__ __forceinline__ void attn_pair_body(const bf16* __restrict__ Qb, const bf16* __restrict__ Kh, const bf16* __restrict__ Vh, float* __restrict__ Ob, int NT, char* lds, int tid_in) {
  int tid_l = tid_in; asm volatile("" : "+v"(tid_l)); const int tid = tid_l, wid = __builtin_amdgcn_readfirstlane(tid >> 6), lane = tid & 63, r32 = lane & 31, hi = lane >> 5;
  const int rg = wid & 3, vhw = wid >> 2;
  char* V_lds = lds + AP_V; char* K_lds = lds + AP_K;
  char* Pp = lds + AP_P + rg * 8192;
  float* ALp = (float*)(lds + AP_AL) + rg * 64; float* Mp = (float*)(lds + AP_M) + rg * 32; unsigned* FLp = (unsigned*)(lds + AP_FL) + rg * 2; float* LXp = (float*)(lds + AP_LX) + rg * 64;
  float m_reg = -1e30f, l_reg = 0.f; f32x16 o[4] = {}; bf16x8 qr[8];
  const bf16* Qw = Qb + (long)(rg * QBLK + r32) * LDQ + hi * 8;
#pragma unroll
  for (int d0 = 0; d0 < 8; ++d0) qr[d0] = *reinterpret_cast<const bf16x8*>(Qw + d0 * 16);
  const int sr = tid >> 4, sc = (tid & 15) * 8, vst0 = v_st(sr, sc), vst1 = v_st(32 + sr, sc);
  const int vb0 = (int)(uintptr_t)(V_lds + vhw * 16384) + v_rd_base(lane);
  bf16x8 ks0, ks1, vs00, vs01, vs10, vs11;
#define KLOAD(k0) do { ks0 = *reinterpret_cast<const bf16x8*>(&Kh[(long)((k0) + sr) * LDK + sc]); ks1 = *reinterpret_cast<const bf16x8*>(&Kh[(long)((k0) + 32 + sr) * LDK + sc]); } while (0)
#define VLOAD(k0) do { vs00 = *reinterpret_cast<const bf16x8*>(&Vh[(long)((k0) + sr) * LDK + sc]); vs01 = *reinterpret_cast<const bf16x8*>(&Vh[(long)((k0) + 32 + sr) * LDK + sc]); \
    vs10 = *reinterpret_cast<const bf16x8*>(&Vh[(long)((k0) + sr) * LDK + 128 + sc]); vs11 = *reinterpret_cast<const bf16x8*>(&Vh[(long)((k0) + 32 + sr) * LDK + 128 + sc]); } while (0)
#define KWRITE(b) do { const int kc = sc * 2; *(bf16x8*)(K_lds + (b) * 16384 + KSWZ(sr, kc)) = ks0; *(bf16x8*)(K_lds + (b) * 16384 + KSWZ(32 + sr, kc)) = ks1; } while (0)
#define VWRITE(b) do { *(bf16x8*)(V_lds + (b) * 32768 + vst0) = vs00; *(bf16x8*)(V_lds + (b) * 32768 + vst1) = vs01; \
    *(bf16x8*)(V_lds + (b) * 32768 + 16384 + vst0) = vs10; *(bf16x8*)(V_lds + (b) * 32768 + 16384 + vst1) = vs11; } while (0)
  KLOAD(0); asm volatile("s_waitcnt vmcnt(0)" ::: "memory"); KWRITE(0);
  if (NT > 1) { KLOAD(KVBLK); asm volatile("s_waitcnt vmcnt(0)" ::: "memory"); KWRITE(1); }
  if (NT > 2) KLOAD(2 * KVBLK);
  VLOAD(0);
  __syncthreads();
  f32x16 p0 = f32x16{}, p1 = f32x16{};
  if (vhw == 0) { qkt_batched(p0, p1, (const bf16*)K_lds, qr, r32, hi); }
  __syncthreads();
#pragma unroll 1
  for (int j = 0; j <= NT; ++j) {
    const int b = j & 1, pb = b ^ 1;
    const bool prod = (j < NT) && (b == vhw);
    if (prod) __builtin_amdgcn_s_setprio(2); else __builtin_amdgcn_s_setprio(0);
    const bool flp = (j >= 1) && (__builtin_amdgcn_readfirstlane((int)FLp[pb]) != 0);
    const float alp_v = ALp[pb * 32 + r32], m_v = Mp[r32];
    const bf16x8 a0 = *reinterpret_cast<const bf16x8*>(Pp + pb * 4096 + 0 * 1024 + lane * 16), a1 = *reinterpret_cast<const bf16x8*>(Pp + pb * 4096 + 1 * 1024 + lane * 16);
    const bf16x8 a2 = *reinterpret_cast<const bf16x8*>(Pp + pb * 4096 + 2 * 1024 + lane * 16), a3 = *reinterpret_cast<const bf16x8*>(Pp + pb * 4096 + 3 * 1024 + lane * 16);
    SBAR();
    KWRITE(b);
    VWRITE(b);
    { const int tk = j + 3 < NT ? j + 3 : NT - 1, tv = j + 1 < NT ? j + 1 : NT - 1; KLOAD(tk * KVBLK); VLOAD(tv * KVBLK); }
    SBAR();
    if (prod) {
      if (flp) l_reg *= alp_v;
      if (j >= 1) m_reg = m_v;
      float mn, al; bf16x8 pa0, pa1, pa2, pa3;
      partialSM(p0, p1, m_reg, mn, al);
      finishSM(p0, p1, al, l_reg, pa0, pa1, pa2, pa3);
      *reinterpret_cast<bf16x8*>(Pp + b * 4096 + 0 * 1024 + lane * 16) = pa0; *reinterpret_cast<bf16x8*>(Pp + b * 4096 + 1 * 1024 + lane * 16) = pa1;
      *reinterpret_cast<bf16x8*>(Pp + b * 4096 + 2 * 1024 + lane * 16) = pa2; *reinterpret_cast<bf16x8*>(Pp + b * 4096 + 3 * 1024 + lane * 16) = pa3;
      if (hi == 0) { ALp[b * 32 + r32] = al; Mp[r32] = m_reg; }
      const unsigned fl = __any(al < 1.f) ? 1u : 0u;
      if (lane == 0) FLp[b] = fl;
      SBAR();
    }
    if (j >= 1) {
      if (flp) {
#pragma unroll
        for (int d = 0; d < 4; ++d)
#pragma unroll
          for (int r = 0; r < 16; ++r) o[d][r] *= ALp[pb * 32 + crow(r, hi)];
      }
      pv_batched(o, vb0 + pb * 32768, a0, a1, a2, a3);
    }
    if (!prod && j + 1 < NT) { SBAR(); qkt_batched(p0, p1, (const bf16*)(K_lds + pb * 16384), qr, r32, hi); SBAR(); }
    __syncthreads();
  }
  __builtin_amdgcn_s_setprio(0);
  if (hi == 0) LXp[vhw * 32 + r32] = l_reg;
  __syncthreads();
  float rli[16];
#pragma unroll
  for (int r = 0; r < 16; ++r) rli[r] = __builtin_amdgcn_rcpf(LXp[crow(r, hi)] + LXp[32 + crow(r, hi)]);
  float* Ow = Ob + (long)(rg * QBLK) * LDO + vhw * 128;
#pragma unroll
  for (int r = 0; r < 16; ++r) { int orow = crow(r, hi);
    for (int d0 = 0; d0 < 4; ++d0) Ow[(long)orow * LDO + d0 * 32 + r32] = o[d0][r] * rli[r]; }
  __syncthreads();
#undef KLOAD
#undef VLOAD
#undef KWRITE
#undef VWRITE
}
#undef KSWZ
#undef SBAR
}

constexpr int DM = 2048, SEQ = 16384, CTXN = 256, MR = SEQ + CTXN  , DEPTH = 4;
constexpr int ATTN_IN = 4608, DN_INP = 12544  , DN_IN = 12416, FFH = 5632, FFU = 2 * FFH;
constexpr float EPS = 1e-6f;
constexpr int NWAVES = 8;
constexpr size_t MiB = 1u << 20;
constexpr size_t WS_CTL = 0, CTL_ZERO_BYTES = 64 * 1024;
constexpr size_t WS_MOD = 1 * MiB;
constexpr size_t WS_ROPE = WS_MOD + 512 * 1024;
constexpr size_t WS_LAM = WS_ROPE + 128 * 1024;
constexpr size_t WS_WIN = 2 * MiB, WS_WOUT = 51 * MiB, WS_WUP = 67 * MiB, WS_WDN = 111 * MiB;
constexpr size_t WS_X = 134 * MiB;
constexpr size_t WS_Z = 264 * MiB;
constexpr size_t WS_R1 = 394 * MiB;
constexpr size_t WS_H = WS_R1;
constexpr size_t WS_HM_ATT = WS_R1 + 65 * MiB;
constexpr size_t WS_QKRM = WS_R1;
constexpr size_t WS_VT = WS_R1 + 130 * MiB;
constexpr size_t WS_KT = WS_R1 + 260 * MiB;
constexpr size_t WS_QF = WS_R1 + 325 * MiB;
constexpr size_t WS_O = WS_R1;
constexpr size_t WS_BG = WS_R1 + 390 * MiB;
constexpr size_t WS_GATES = WS_BG + 9 * MiB;
constexpr size_t WS_R2 = WS_GATES + 9 * MiB;
constexpr size_t WS_ITEMS = WS_R2;
constexpr size_t WS_RAW = WS_R2;
constexpr size_t WS_HM_DN = WS_R2;
constexpr size_t WS_QKV = WS_R2;
constexpr size_t WS_OA = WS_R2 + 147 * MiB;
constexpr size_t WS_OB = WS_OA + 130 * MiB;
constexpr size_t WS_U = WS_R2;
constexpr size_t WS_A2 = WS_R2 + 358 * MiB;
constexpr size_t WS_P = WS_R2 + 538 * MiB;
constexpr size_t WS_END = WS_R2 + 667 * MiB;
static_assert(WS_END <= 1536 * MiB, "workspace map exceeds 1536 MiB");
static_assert(WS_R2 == 802 * MiB && WS_A2 + (size_t)MR * FFH * 2 <= WS_END && WS_OB + (size_t)MR * 1024 * 4 <= WS_END && WS_ITEMS + (size_t)260 * 64 * 41984 <= WS_END, "ws map");
constexpr int CW_BAR = 1024;

constexpr int RING_BYTES = 131072;
constexpr int LDS_BYTES = 163840;
constexpr int MISC_OFF = LDS_BYTES - 256, ARGT_OFF = LDS_BYTES - 512;

#define GAS __attribute__((address_space(1)))
#define LAS __attribute__((address_space(3)))
typedef unsigned short bf16;
typedef unsigned v4u __attribute__((ext_vector_type(4)));
typedef unsigned v2u __attribute__((ext_vector_type(2)));
typedef float f32x4 __attribute__((ext_vector_type(4)));
__device__ __forceinline__ const float* lds_arg(__attribute__((address_space(3))) unsigned char* lds, int i) { const unsigned long long v = *(const __attribute__((address_space(3))) unsigned long long*)(lds + ARGT_OFF + i * 8);
    return (const float*)(((unsigned long long)(unsigned)__builtin_amdgcn_readfirstlane((int)(v >> 32)) << 32) | (unsigned long long)(unsigned)__builtin_amdgcn_readfirstlane((int)(unsigned)v)); }
#define AIN(i) lds_arg(F.lds, (i))
#define LDS_WAIT() asm volatile("s_waitcnt lgkmcnt(0)" ::: "memory")
#define VM_WAIT() asm volatile("s_waitcnt vmcnt(0)" ::: "memory")
typedef float f32x2_cv __attribute__((ext_vector_type(2))); typedef __bf16 bf16x2_cv __attribute__((ext_vector_type(2)));
__device__ __forceinline__ unsigned pk2(float lo, float hi) { const f32x2_cv v = {lo, hi}; const bf16x2_cv b = __builtin_convertvector(v, bf16x2_cv); return __builtin_bit_cast(unsigned, b); }
__device__ __forceinline__ float bflo(unsigned u) { return __uint_as_float(u << 16); }
__device__ __forceinline__ float bfhi(unsigned u) { return __uint_as_float(u & 0xffff0000u); }
__device__ __forceinline__ float bf2f(bf16 b) { return __uint_as_float(((unsigned)b) << 16); }
__device__ __forceinline__ float siluf(float x) { return x / (1.f + __expf(-x)); }
__device__ __forceinline__ float shx(float v, int mask, int lane) { return __int_as_float(__builtin_amdgcn_ds_bpermute((lane ^ mask) << 2, __float_as_int(v))); }
__device__ __forceinline__ float shl_from(float v, int src_lane) { return __int_as_float(__builtin_amdgcn_ds_bpermute(src_lane << 2, __float_as_int(v))); }
__device__ __forceinline__ float wave_sum(float v, int lane) {
#pragma unroll
    for (int o = 1; o < 64; o <<= 1) v += shx(v, o, lane);
    return v;
}
#define XB_TMO      128
#define XB_XCNT(j)  (256  + 64 * (j))
#define XB_XSUB(j)  (1280 + 64 * (j))
#define XB_XGEN(j)  (2304 + 64 * (j))
#define XB_TOP      3328
#define XB_TOPGEN   3392
#define XCD_BAR_WORDS 3456
#define XB_SPIN_CAP (1u << 20)

__device__ __forceinline__ unsigned xb_ld(unsigned* p)              { return __hip_atomic_load(p, __ATOMIC_RELAXED, __HIP_MEMORY_SCOPE_AGENT); }
__device__ __forceinline__ unsigned xb_add(unsigned* p, unsigned v) { return __hip_atomic_fetch_add(p, v, __ATOMIC_RELAXED, __HIP_MEMORY_SCOPE_AGENT); }
__device__ __forceinline__ unsigned xb_xcc_id() { return (unsigned)__builtin_amdgcn_s_getreg((3 << 11) | 20) & 0xFu; }
#define XB_SPIN(cond, bar) do { unsigned _sp = 0; while (cond) { __builtin_amdgcn_s_sleep(4); \
    if ((++_sp & 255u) == 0u) { if (xb_ld(&(bar)[XB_TMO])) break; if (_sp > XB_SPIN_CAP) { atomicAdd(&(bar)[XB_TMO], 1u); break; } } } } while (0)

struct XcdBarrier {
    unsigned* bar; unsigned x;
    volatile LAS unsigned* st;
};

__device__ __forceinline__ XcdBarrier xcd_barrier_post(unsigned* bar, volatile LAS unsigned* st) {
    XcdBarrier b; b.bar = bar; b.x = xb_xcc_id(); b.st = st;
    if (threadIdx.x == 0) (void)xb_add(&bar[XB_XCNT(b.x)], 1u);
    return b;
}
__device__ __forceinline__ void xcd_barrier_complete(unsigned* bar, unsigned x, unsigned& nloc, unsigned& nx) {
    const unsigned G = gridDim.x * gridDim.y * gridDim.z;
    unsigned sum, cnt, mine, sp = 0u;
    for (;;) {
        sum = 0u; cnt = 0u; mine = 0u;
#pragma unroll
        for (unsigned j = 0; j < 16; ++j) { const unsigned c = xb_ld(&bar[XB_XCNT(j)]); sum += c; cnt += (c > 0u) ? 1u : 0u; mine = (j == x) ? c : mine; }
        if (sum == G) break;
        __builtin_amdgcn_s_sleep(4);
        if ((++sp & 255u) == 0u) { if (xb_ld(&bar[XB_TMO])) break; if (sp > XB_SPIN_CAP) { atomicAdd(&bar[XB_TMO], 1u); break; } }
    }
    nloc = mine > 0u ? mine : 1u; nx = cnt > 0u ? cnt : 1u;
}

__device__ __forceinline__ void xcd_barrier(const XcdBarrier& b) {
    asm volatile("s_waitcnt vmcnt(0)" ::: "memory");
    __syncthreads();
    if (threadIdx.x == 0) {
        unsigned* bar = b.bar;
        __builtin_amdgcn_s_waitcnt(0);
        unsigned nloc = b.st[0], nx = b.st[1];
        if (nloc == 0u) { xcd_barrier_complete(bar, b.x, nloc, nx); b.st[0] = nloc; b.st[1] = nx; }
        const unsigned old = xb_add(&bar[XB_XSUB(b.x)], 1u);
        const unsigned gen = old / nloc;
        if (old + 1u == (gen + 1u) * nloc) {
            __builtin_amdgcn_fence(__ATOMIC_RELEASE, "agent");
            asm volatile("s_waitcnt vmcnt(0)" ::: "memory");
            const unsigned og = xb_add(&bar[XB_TOP], 1u);
            const unsigned tg = og / nx;
            if (og + 1u == (tg + 1u) * nx) xb_add(&bar[XB_TOPGEN], 1u);
            else XB_SPIN(xb_ld(&bar[XB_TOPGEN]) == tg, bar);
            __builtin_amdgcn_fence(__ATOMIC_ACQUIRE, "agent");
            xb_add(&bar[XB_XGEN(b.x)], 1u);
            asm volatile("s_waitcnt vmcnt(0)" ::: "memory");
        } else {
            XB_SPIN(xb_ld(&bar[XB_XGEN(b.x)]) == gen, bar);
            __builtin_amdgcn_fence(__ATOMIC_ACQUIRE, "agent");
            asm volatile("s_waitcnt vmcnt(0)" ::: "memory");
        }
    }
    __syncthreads();
}

struct Frame {
    LAS unsigned char* lds;
    int tid, lane, wave, G, gw, NGW;
};
struct Args { const float* in[23]; float* out; unsigned char* ws; int ph_lo, ph_hi, use_bar, pad; };
enum { I_X = 0, I_C, I_CTX, I_CCTX, I_WMOD, I_BMOD, I_N1G, I_N2G, I_AWIN, I_DLAM, I_SUBLN, I_SINK, I_AWOUT, I_DWIN, I_DCONV, I_DALOG, I_DDT, I_DNG, I_DWOUT, I_FUP, I_FCONV, I_FDN, I_FING };

__device__ __forceinline__ void p0_prologue(const Frame& F, unsigned char* ws) {
    const size_t gtid = (size_t)blockIdx.x * 512 + F.tid, NT = (size_t)F.G * 512;
    {
        f32x4* X4 = (f32x4*)(ws + WS_X); const f32x4* c4 = (const f32x4*)AIN(I_CTX); const f32x4* x4 = (const f32x4*)AIN(I_X);
        const size_t n4c = (size_t)CTXN * DM / 4, n4x = (size_t)SEQ * DM / 4;
        for (size_t i = gtid; i < n4c; i += NT) X4[i] = c4[i];
        for (size_t i = gtid; i < n4x; i += NT) X4[n4c + i] = x4[i];
    }
    {
        float* rope = (float*)(ws + WS_ROPE);
        for (size_t i = gtid; i < 8192; i += NT) { const int pos = (int)(i >> 5), f = (int)(i & 31); const float inv = powf(10000.f, -(float)f / 32.f); const float ang = (float)pos * inv;
            rope[i] = cosf(ang); rope[8192 + i] = sinf(ang); }
    }
    if (blockIdx.x == 0 && F.tid < 2) {
        const float* lf = AIN(I_DLAM) + F.tid * 512; float s01 = 0.f, s23 = 0.f;
        for (int d = 0; d < 128; ++d) { s01 += lf[d] * lf[128 + d]; s23 += lf[256 + d] * lf[384 + d]; }
        const float lam_init = F.tid == 0 ? 0.2f : 0.4707130183435842f;
        ((float*)(ws + WS_LAM))[F.tid] = expf(s01) - expf(s23) + lam_init;
    }
    {
        LAS float* sl = (LAS float*)F.lds; LAS float* sc = sl + 2048; LAS float* red = sc + 2048;
        for (int k = F.tid; k < 2048; k += 512) { sl[k] = siluf(AIN(I_C)[k]); sc[k] = siluf(AIN(I_CCTX)[k]); }
        __syncthreads();
        float* MOD = (float*)(ws + WS_MOD);
        for (int it = blockIdx.x; it < 192; it += F.G) {
            const int layer = it / 48, nb = it % 48, n = nb * 256 + F.lane * 4;
            const float* W = AIN(I_WMOD) + (size_t)layer * 2048 * 12288 + n;
            f32x4 al = (f32x4){0.f, 0.f, 0.f, 0.f}, ac = al;
            const int k0 = F.wave * 256;
#pragma unroll 8
            for (int k = k0; k < k0 + 256; ++k) { const f32x4 w = *(const f32x4*)(W + (size_t)k * 12288); al += sl[k] * w; ac += sc[k] * w; }
            *(LAS f32x4*)(red + (F.wave * 2 + 0) * 256 + F.lane * 4) = al; *(LAS f32x4*)(red + (F.wave * 2 + 1) * 256 + F.lane * 4) = ac;
            __syncthreads();
            { const int which = F.tid >> 8, col = F.tid & 255; float s = AIN(I_BMOD)[layer * 12288 + nb * 256 + col];
#pragma unroll
              for (int w = 0; w < 8; ++w) s += red[(w * 2 + which) * 256 + col];
              MOD[(size_t)(layer * 2 + which) * 12288 + nb * 256 + col] = s; }
            __syncthreads();
        }
    }
}

__device__ __forceinline__ void transpose_item(const float* W, int K, int N, bf16* WT, LAS float* scr, int item, int lane, bool ropemode) {
    const int nblk = N / 32, kb = item / nblk, nb = item % nblk, k0 = 64 * kb, n0 = 32 * nb;
    int src = n0 + (lane & 31);
    if (ropemode) { const int blk = src >> 8; if (blk < 8 || (blk >= 12 && blk <= 16)) { const int p = src & 127, j = p >> 3, i = p & 7; src = (src & ~127) + 64 * (j >> 3) + 4 * (j & 7) + (i & 3) + 32 * (i >> 2); } }
    float wv[32];
#pragma unroll
    for (int i = 0; i < 32; ++i) { const int kk = 2 * i + (lane >> 5); wv[i] = W[(size_t)(k0 + kk) * N + src]; }
#pragma unroll
    for (int i = 0; i < 32; ++i) { const int kk = 2 * i + (lane >> 5); scr[kk * 33 + (lane & 31)] = wv[i]; }
    LDS_WAIT(); asm volatile("" ::: "memory");
    const int c = lane & 7;
#pragma unroll
    for (int j = 0; j < 4; ++j) { const int n = (lane >> 3) + 8 * j; const LAS float* s = scr + (8 * c) * 33 + n;
        v4u o; o.x = pk2(s[0 * 33], s[1 * 33]); o.y = pk2(s[2 * 33], s[3 * 33]); o.z = pk2(s[4 * 33], s[5 * 33]); o.w = pk2(s[6 * 33], s[7 * 33]);
        *(v4u*)(WT + (size_t)(n0 + n) * K + k0 + 8 * c) = o; }
    LDS_WAIT(); asm volatile("" ::: "memory");
}
__device__ __forceinline__ void convert_layer_weights(const Frame& F, unsigned char* ws, int layer) {
    const int li = layer >> 1;
    LAS float* scr = (LAS float*)(F.lds + 32768 + F.wave * 8448);
    bf16* WIN = (bf16*)(ws + WS_WIN); bf16* WOUT = (bf16*)(ws + WS_WOUT); bf16* WUP = (bf16*)(ws + WS_WUP); bf16* WDN = (bf16*)(ws + WS_WDN);
    const float* up = AIN(I_FUP) + (size_t)layer * DM * FFU; const float* dn = AIN(I_FDN) + (size_t)layer * FFH * DM;
    const int I_up = (DM / 64) * (FFU / 32), I_dn = (FFH / 64) * (DM / 32);
    if ((layer & 1) == 0) {
        const float* win = AIN(I_AWIN) + (size_t)li * DM * ATTN_IN; const float* wout = AIN(I_AWOUT) + (size_t)li * DM * DM;
        const int I_in = (DM / 64) * (ATTN_IN / 32), I_out = (DM / 64) * (DM / 32), NI = I_in + I_out + I_up + I_dn;
        for (int it = F.gw; it < NI; it += F.NGW) { int r = it;
            if (r < I_in) { transpose_item(win, DM, ATTN_IN, WIN, scr, r, F.lane, true); continue; } r -= I_in;
            if (r < I_out) { transpose_item(wout, DM, DM, WOUT, scr, r, F.lane, false); continue; } r -= I_out;
            if (r < I_up) { transpose_item(up, DM, FFU, WUP, scr, r, F.lane, false); continue; } r -= I_up;
            transpose_item(dn, FFH, DM, WDN, scr, r, F.lane, false); }
    } else {
        const float* win = AIN(I_DWIN) + (size_t)li * DM * DN_IN; const float* wout = AIN(I_DWOUT) + (size_t)li * 4096 * DM;
        const int I_in = (DM / 64) * (DN_IN / 32), I_out = (4096 / 64) * (DM / 32), NI = I_in + I_out + I_up + I_dn;
        for (int it = F.gw; it < NI; it += F.NGW) { int r = it;
            if (r < I_in) { transpose_item(win, DM, DN_IN, WIN, scr, r, F.lane, false); continue; } r -= I_in;
            if (r < I_out) { transpose_item(wout, 4096, DM, WOUT, scr, r, F.lane, false); continue; } r -= I_out;
            if (r < I_up) { transpose_item(up, DM, FFU, WUP, scr, r, F.lane, false); continue; } r -= I_up;
            transpose_item(dn, FFH, DM, WDN, scr, r, F.lane, false); }
        v4u* z = (v4u*)(WIN + (size_t)DN_IN * DM); const size_t nz = (size_t)(DN_INP - DN_IN) * DM * 2 / 16;
        for (size_t i = (size_t)blockIdx.x * 512 + F.tid; i < nz; i += (size_t)F.G * 512) z[i] = (v4u){0u, 0u, 0u, 0u};
    }
}

__device__ __forceinline__ void norm_phase(const Frame& F, float* X, bf16* H, const float* gain, const float* mod_lat, const float* mod_ctx, int sh_chunk, const float* P, int pend_ks, const float* pend_gate) {
    LAS float* V = (LAS float*)F.lds;
    for (int k = F.tid; k < 2048; k += 512) { const float g = gain[k];
        V[k] = g * (1.f + mod_lat[(sh_chunk + 1) * 2048 + k]); V[2048 + k] = mod_lat[sh_chunk * 2048 + k];
        V[4096 + k] = g * (1.f + mod_ctx[(sh_chunk + 1) * 2048 + k]); V[6144 + k] = mod_ctx[sh_chunk * 2048 + k]; }
    __syncthreads();
    for (int r = F.gw; r < MR; r += F.NGW) {
        const f32x4* xr = (const f32x4*)(X + (size_t)r * DM) + F.lane; const LAS float* A = V + (r < CTXN ? 4096 : 0); const LAS float* B = A + 2048;
        f32x4 v[8]; float ss = 0.f;
#pragma unroll
        for (int j = 0; j < 8; ++j) v[j] = xr[64 * j];
        if (pend_ks > 0 && r < CTXN) {
            f32x4 acc[8];
#pragma unroll
            for (int j = 0; j < 8; ++j) acc[j] = (f32x4){0.f, 0.f, 0.f, 0.f};
            for (int ks = 0; ks < pend_ks; ++ks) { const f32x4* pr = (const f32x4*)(P + ((size_t)ks * CTXN + r) * DM) + F.lane;
#pragma unroll
                for (int j = 0; j < 8; ++j) acc[j] += pr[64 * j]; }
            f32x4* xw = (f32x4*)(X + (size_t)r * DM) + F.lane;
#pragma unroll
            for (int j = 0; j < 8; ++j) { v[j] += *((const f32x4*)pend_gate + F.lane + 64 * j) * acc[j]; xw[64 * j] = v[j]; }
        }
#pragma unroll
        for (int j = 0; j < 8; ++j) ss += (v[j].x * v[j].x + v[j].y * v[j].y) + (v[j].z * v[j].z + v[j].w * v[j].w);
        const float rstd = rsqrtf(wave_sum(ss, F.lane) * (1.f / DM) + EPS);
        v2u* o8 = (v2u*)(H + (size_t)r * DM) + F.lane;
#pragma unroll
        for (int j = 0; j < 8; ++j) { const int col = (F.lane + 64 * j) * 4; const f32x4 av = *(const LAS f32x4*)(A + col), bv = *(const LAS f32x4*)(B + col);
            const f32x4 y = v[j] * rstd * av + bv; v2u w; w.x = pk2(y.x, y.y); w.y = pk2(y.z, y.w); o8[64 * j] = w; }
    }
    __syncthreads();
}

__device__ __forceinline__ void merge_phase(const Frame& F, const float* OA, const float* OB, bf16* HM, const float* subln, float lam, float lam_init) {
    const f32x4 g = *((const f32x4*)subln + F.lane);
    for (int r = F.gw; r < MR; r += F.NGW) {
        const f32x4* oa = (const f32x4*)(OA + (size_t)r * 2048) + F.lane; v2u* hm = (v2u*)(HM + (size_t)r * 2048) + F.lane;
#pragma unroll
        for (int h = 0; h < 4; ++h) { const f32x4 o0 = oa[h * 128], o1 = oa[h * 128 + 64]; const f32x4 d = o0 - lam * o1;
            const float ss = wave_sum((d.x * d.x + d.y * d.y) + (d.z * d.z + d.w * d.w), F.lane);
            const float rs = rsqrtf(ss * (1.f / 256.f) + EPS) * (1.f - lam_init); const f32x4 y = d * rs * g;
            v2u w; w.x = pk2(y.x, y.y); w.y = pk2(y.z, y.w); hm[h * 64] = w; }
        const f32x4* ob = (const f32x4*)(OB + (size_t)r * 1024) + F.lane;
#pragma unroll
        for (int j = 0; j < 4; ++j) { const f32x4 y = ob[64 * j]; v2u w; w.x = pk2(y.x, y.y); w.y = pk2(y.z, y.w); hm[256 + 64 * j] = w; }
    }
}

struct Row8 { float v[8]; };
__device__ __forceinline__ Row8 unpack8(v4u p) { Row8 r; r.v[0] = bflo(p.x); r.v[1] = bfhi(p.x); r.v[2] = bflo(p.y); r.v[3] = bfhi(p.y); r.v[4] = bflo(p.z); r.v[5] = bfhi(p.z); r.v[6] = bflo(p.w); r.v[7] = bfhi(p.w); return r; }

__device__ __forceinline__ void convgate_phase(const Frame& F, const bf16* U, bf16* A2, const float* cw, int run0) {
    constexpr int NSTRIP = FFH / 512, NRUN = MR / 32;
    for (int it = F.gw + run0 * NSTRIP; it < NSTRIP * NRUN; it += F.NGW) {
        const int strip = it % NSTRIP, run = it / NSTRIP, c0 = strip * 512 + F.lane * 8, r0 = run * 32;
        const int seg_lo = r0 < CTXN ? 0 : CTXN, seg_hi = r0 < CTXN ? CTXN : MR;
        float wg[3][8], wu[3][8];
#pragma unroll
        for (int t = 0; t < 3; ++t)
#pragma unroll
            for (int i = 0; i < 8; ++i) { wg[t][i] = cw[t * FFU + c0 + i]; wu[t][i] = cw[t * FFU + FFH + c0 + i]; }
        const v4u zero = (v4u){0u, 0u, 0u, 0u};
#pragma unroll 1
        for (int g8 = 0; g8 < 4; ++g8) {
            v4u gr[10], ur[10];
#pragma unroll
            for (int k = 0; k < 10; ++k) { const int rk = r0 + g8 * 8 - 1 + k; const bool ok = rk >= seg_lo && rk < seg_hi;
                gr[k] = ok ? *(const v4u*)(U + (size_t)rk * FFU + c0) : zero; ur[k] = ok ? *(const v4u*)(U + (size_t)rk * FFU + FFH + c0) : zero; }
#pragma unroll
            for (int rr = 0; rr < 8; ++rr) {
                const int r = r0 + g8 * 8 + rr;
                const Row8 a0 = unpack8(gr[rr]), a1 = unpack8(gr[rr + 1]), a2 = unpack8(gr[rr + 2]), b0 = unpack8(ur[rr]), b1 = unpack8(ur[rr + 1]), b2 = unpack8(ur[rr + 2]);
                float o[8];
#pragma unroll
                for (int i = 0; i < 8; ++i) { const float g = wg[0][i] * a0.v[i] + wg[1][i] * a1.v[i] + wg[2][i] * a2.v[i]; const float u = wu[0][i] * b0.v[i] + wu[1][i] * b1.v[i] + wu[2][i] * b2.v[i]; o[i] = siluf(g) * u; }
                v4u w; w.x = pk2(o[0], o[1]); w.y = pk2(o[2], o[3]); w.z = pk2(o[4], o[5]); w.w = pk2(o[6], o[7]);
                *(v4u*)(A2 + (size_t)r * FFH + c0) = w;
            }
        }
    }
}

__device__ __forceinline__ void dnconv_phase(const Frame& F, const bf16* RAW, bf16* QKVN, const float* cw, const float* GATES, float* BG, const float* a_log, const float* dt_bias) {
    constexpr int NSTRIP = 8192 / 512, NRUN = MR / 32;
    for (int it = F.gw; it < NSTRIP * NRUN; it += F.NGW) {
        const int strip = it % NSTRIP, run = it / NSTRIP, c0 = strip * 512 + F.lane * 8, r0 = run * 32;
        const int seg_lo = r0 < CTXN ? 0 : CTXN, seg_hi = r0 < CTXN ? CTXN : MR;
        float w[3][8];
#pragma unroll
        for (int t = 0; t < 3; ++t)
#pragma unroll
            for (int i = 0; i < 8; ++i) w[t][i] = cw[t * 8192 + c0 + i];
        const v4u zero = (v4u){0u, 0u, 0u, 0u};
        v4u xp = zero, xc;
        if (r0 - 1 >= seg_lo) xp = *(const v4u*)(RAW + (size_t)(r0 - 1) * 8192 + c0);
        xc = *(const v4u*)(RAW + (size_t)r0 * 8192 + c0);
        const float qscale = strip < 4 ? 0.088388347648318440f : 1.f;
        for (int r = r0; r < r0 + 32; ++r) {
            v4u xn = zero;
            if (r + 1 < seg_hi) xn = *(const v4u*)(RAW + (size_t)(r + 1) * 8192 + c0);
            const Row8 a0 = unpack8(xp), a1 = unpack8(xc), a2 = unpack8(xn);
            float o[8]; float ss = 0.f;
#pragma unroll
            for (int i = 0; i < 8; ++i) { o[i] = siluf(w[0][i] * a0.v[i] + w[1][i] * a1.v[i] + w[2][i] * a2.v[i]); ss += o[i] * o[i]; }
            if (strip < 8) {
                ss += shx(ss, 1, F.lane); ss += shx(ss, 2, F.lane); ss += shx(ss, 4, F.lane); ss += shx(ss, 8, F.lane);
                const float sc = rsqrtf(ss + EPS) * qscale;
#pragma unroll
                for (int i = 0; i < 8; ++i) o[i] *= sc;
            }
            v4u wv; wv.x = pk2(o[0], o[1]); wv.y = pk2(o[2], o[3]); wv.z = pk2(o[4], o[5]); wv.w = pk2(o[6], o[7]);
            *(v4u*)(QKVN + (size_t)r * 8192 + c0) = wv;
            xp = xc; xc = xn;
        }
    }
    for (size_t i = (size_t)blockIdx.x * 512 + F.tid; i < (size_t)MR * 64; i += (size_t)F.G * 512) {
        const int r = (int)(i >> 6), e = (int)(i & 63), dir = e >> 5, hv = e & 31;
        const float gb = GATES[(size_t)r * 128 + dir * 64 + hv], ga = GATES[(size_t)r * 128 + dir * 64 + 32 + hv] + dt_bias[e];
        const float sp = fmaxf(ga, 0.f) + log1pf(expf(-fabsf(ga)));
        BG[i] = 1.f / (1.f + expf(-gb)); BG[(size_t)MR * 64 + i] = -expf(a_log[e]) * sp;
    }
}

__device__ __forceinline__ void dnout_phase(const Frame& F, const float* OF, const float* OR, const bf16* Z, bf16* HM, const float* gn) {
    const int d0 = (F.lane & 15) * 8;
    float g[8];
#pragma unroll
    for (int i = 0; i < 8; ++i) g[i] = gn[d0 + i];
    for (int it = F.gw; it < MR * 8; it += F.NGW) {
        const int r = it >> 3, c0 = (it & 7) * 512 + F.lane * 8;
        const f32x4 a0 = *(const f32x4*)(OF + (size_t)r * 4096 + c0), a1 = *(const f32x4*)(OF + (size_t)r * 4096 + c0 + 4);
        const f32x4 b0 = *(const f32x4*)(OR + (size_t)r * 4096 + c0), b1 = *(const f32x4*)(OR + (size_t)r * 4096 + c0 + 4);
        const Row8 z = unpack8(*(const v4u*)(Z + (size_t)r * 4096 + c0));
        float o[8] = {a0.x + b0.x, a0.y + b0.y, a0.z + b0.z, a0.w + b0.w, a1.x + b1.x, a1.y + b1.y, a1.z + b1.z, a1.w + b1.w};
        float ss = 0.f;
#pragma unroll
        for (int i = 0; i < 8; ++i) ss += o[i] * o[i];
        ss += shx(ss, 1, F.lane); ss += shx(ss, 2, F.lane); ss += shx(ss, 4, F.lane); ss += shx(ss, 8, F.lane);
        const float rs = rsqrtf(ss * (1.f / 128.f) + EPS);
#pragma unroll
        for (int i = 0; i < 8; ++i) o[i] = o[i] * rs * g[i] * siluf(z.v[i]);
        v4u w; w.x = pk2(o[0], o[1]); w.y = pk2(o[2], o[3]); w.z = pk2(o[4], o[5]); w.w = pk2(o[6], o[7]);
        *(v4u*)(HM + (size_t)r * 4096 + c0) = w;
    }
}

__device__ __forceinline__ void final_phase(const Frame& F, const float* X, float* out, const float* gain) {
    f32x4 gv[8];
#pragma unroll
    for (int j = 0; j < 8; ++j) gv[j] = *((const f32x4*)gain + F.lane + 64 * j);
    for (int t = F.gw; t < SEQ; t += F.NGW) {
        const f32x4* xr = (const f32x4*)(X + (size_t)(CTXN + t) * DM) + F.lane; f32x4* orow = (f32x4*)(out + (size_t)t * DM) + F.lane;
        f32x4 v[8]; float ss = 0.f;
#pragma unroll
        for (int j = 0; j < 8; ++j) { v[j] = xr[64 * j]; ss += (v[j].x * v[j].x + v[j].y * v[j].y) + (v[j].z * v[j].z + v[j].w * v[j].w); }
        const float rstd = rsqrtf(wave_sum(ss, F.lane) * (1.f / DM) + EPS);
#pragma unroll
        for (int j = 0; j < 8; ++j) orow[64 * j] = v[j] * rstd * gv[j];
    }
}

__device__ __forceinline__ void dn_recurrent_phase(const Frame& F, const bf16* QKVN, const float* BG, float* OF, float* OR) {
    LAS float* kf = (LAS float*)F.lds; LAS float* qf = kf + 8192; LAS float* vf = qf + 8192; LAS float* gb = vf + 8192; LAS float* ured = gb + 128; LAS float* ored = ured + 512;
    const int j = F.tid & 127, qd = F.tid >> 7;
    for (int item = blockIdx.x; item < 64; item += F.G) {
        const int hv = item >> 1, dir = item & 1, hk = hv >> 1;
        float* O = dir ? OR : OF;
        float S[32];
#pragma unroll
        for (int i = 0; i < 32; ++i) S[i] = 0.f;
        auto row_base = [&](int pc) -> int { return pc < 4 ? (dir ? CTXN - 64 * (pc + 1) : 64 * pc) : CTXN + (dir ? SEQ - 64 * (pc - 3) : 64 * (pc - 4)); };
        v4u sk[2], sq[2], sv[2]; float sg = 0.f;
        auto issue = [&](int pc) { const int rb = row_base(pc);
#pragma unroll
            for (int p = 0; p < 2; ++p) { const int piece = F.tid + 512 * p, rr = piece >> 4, cc = (piece & 15) * 8; const bf16* rp = QKVN + (size_t)(rb + rr) * 8192;
                sk[p] = *(const v4u*)(rp + 2048 + hk * 128 + cc); sq[p] = *(const v4u*)(rp + hk * 128 + cc); sv[p] = *(const v4u*)(rp + 4096 + hv * 128 + cc); }
            if (F.tid < 128) { const int rr = F.tid & 63, which = F.tid >> 6;
                sg = BG[(which ? 0 : (size_t)MR * 64) + (size_t)(rb + rr) * 64 + dir * 32 + hv]; } };
        auto commit = [&]() {
#pragma unroll
            for (int p = 0; p < 2; ++p) { const int piece = F.tid + 512 * p, rr = piece >> 4, cc = (piece & 15) * 8; const Row8 a = unpack8(sk[p]), b = unpack8(sq[p]), c = unpack8(sv[p]);
#pragma unroll
                for (int i = 0; i < 8; ++i) { kf[rr * 128 + cc + i] = a.v[i]; qf[rr * 128 + cc + i] = b.v[i]; vf[rr * 128 + cc + i] = c.v[i]; } }
            if (F.tid < 128) gb[F.tid] = sg; };
        issue(0);
        int par = 0; int prev_row = -1;
        for (int pc = 0; pc < 260; ++pc) {
            __syncthreads();
            commit();
            __syncthreads();
            if (pc + 1 < 260) issue(pc + 1);
            const int rb = row_base(pc);
            for (int tt = 0; tt < 64; ++tt) {
                const int lr = dir ? 63 - tt : tt;
                const LAS f32x4* k4 = (const LAS f32x4*)(kf + lr * 128 + qd * 32); const LAS f32x4* q4 = (const LAS f32x4*)(qf + lr * 128 + qd * 32);
                float kk[32];
                float up = 0.f;
#pragma unroll
                for (int i = 0; i < 8; ++i) { const f32x4 t = k4[i]; kk[4 * i] = t.x; kk[4 * i + 1] = t.y; kk[4 * i + 2] = t.z; kk[4 * i + 3] = t.w; }
#pragma unroll
                for (int i = 0; i < 32; ++i) up += S[i] * kk[i];
                ured[qd * 128 + j] = up;
                __syncthreads();
                if (qd == 0 && prev_row >= 0) {
                    const LAS float* op = ored + (par ^ 1) * 512 + j; O[(size_t)prev_row * 4096 + hv * 128 + j] = (op[0] + op[128]) + (op[256] + op[384]); }
                const float u = (ured[j] + ured[128 + j]) + (ured[256 + j] + ured[384 + j]);
                const float eg = __expf(gb[lr]), beta = gb[64 + lr];
                const float vnew = beta * (vf[lr * 128 + j] - eg * u);
                float opart = 0.f;
#pragma unroll
                for (int i = 0; i < 8; ++i) { const f32x4 t = q4[i];
                    S[4 * i] = S[4 * i] * eg + kk[4 * i] * vnew; S[4 * i + 1] = S[4 * i + 1] * eg + kk[4 * i + 1] * vnew; S[4 * i + 2] = S[4 * i + 2] * eg + kk[4 * i + 2] * vnew; S[4 * i + 3] = S[4 * i + 3] * eg + kk[4 * i + 3] * vnew;
                    opart += S[4 * i] * t.x + S[4 * i + 1] * t.y + S[4 * i + 2] * t.z + S[4 * i + 3] * t.w; }
                ored[par * 512 + qd * 128 + j] = opart;
                prev_row = rb + lr; par ^= 1;
                __syncthreads();
            }
        }
        if (qd == 0) { const LAS float* op = ored + (par ^ 1) * 512 + j; O[(size_t)prev_row * 4096 + hv * 128 + j] = (op[0] + op[128]) + (op[256] + op[384]); }
        __syncthreads();
    }
}

constexpr int NCB = MR / 64;
constexpr int ITEM_W = 0, ITEM_AQK = 16384, ITEM_U = 24576, ITEM_TAB = 40960, ITEM_BYTES = 41984;
typedef short bf16x8_t __attribute__((ext_vector_type(8)));
typedef float f32x16_t __attribute__((ext_vector_type(16)));
__device__ __forceinline__ int crow16(int r, int hi) { return (r & 3) + 8 * (r >> 2) + 4 * hi; }
__device__ __forceinline__ bf16x8_t as_frag(v4u x) { return __builtin_bit_cast(bf16x8_t, x); }

__device__ __forceinline__ void dnconv2_phase(const Frame& F, const bf16* RAW, bf16* QKrm, unsigned char* QF, unsigned char* KT, unsigned char* VT,
                                              const float* cw, const float* GATES, float* BG, const float* a_log, const float* dt_bias) {
    constexpr int NSTRIP = 8192 / 512, NRUN = MR / 32;
    const int Lp = F.lane & 15, hd = F.lane >> 4;
    for (int it = F.gw; it < NSTRIP * NRUN; it += F.NGW) {
        const int strip = it % NSTRIP, run = it / NSTRIP, c0 = strip * 512 + F.lane * 8, r0 = run * 32;
        const int seg_lo = r0 < CTXN ? 0 : CTXN, seg_hi = r0 < CTXN ? CTXN : MR;
        const int cb = run >> 1;
        float w[3][8];
#pragma unroll
        for (int t = 0; t < 3; ++t)
#pragma unroll
            for (int i = 0; i < 8; ++i) w[t][i] = cw[t * 8192 + c0 + i];
        const v4u zero = (v4u){0u, 0u, 0u, 0u};
        const float qscale = strip < 4 ? 0.088388347648318440f : 1.f;
        unsigned char* tbase = nullptr;
        if (strip >= 4 && strip < 8) tbase = KT + ((size_t)cb * 16 + (strip - 4) * 4 + hd) * 16384;
        if (strip >= 8) tbase = VT + ((size_t)cb * 32 + (strip - 8) * 4 + hd) * 16384;
        unsigned char* qbase = QF + ((size_t)cb * 16 + strip * 4 + hd) * 16384;
#pragma unroll 1
        for (int g = 0; g < 2; ++g) {
            unsigned pk[8][8]; float prev[8];
            v4u xr[18];
#pragma unroll
            for (int k = 0; k < 18; ++k) { const int rk = r0 + g * 16 - 1 + k; xr[k] = (rk >= seg_lo && rk < seg_hi) ? *(const v4u*)(RAW + (size_t)rk * 8192 + c0) : zero; }
#pragma unroll
            for (int rr = 0; rr < 16; ++rr) {
                const int r = r0 + g * 16 + rr;
                const Row8 a0 = unpack8(xr[rr]), a1 = unpack8(xr[rr + 1]), a2 = unpack8(xr[rr + 2]);
                float o[8]; float ss = 0.f;
#pragma unroll
                for (int i = 0; i < 8; ++i) { o[i] = siluf(w[0][i] * a0.v[i] + w[1][i] * a1.v[i] + w[2][i] * a2.v[i]); ss += o[i] * o[i]; }
                if (strip < 8) {
                    ss += shx(ss, 1, F.lane); ss += shx(ss, 2, F.lane); ss += shx(ss, 4, F.lane); ss += shx(ss, 8, F.lane);
                    const float sc = rsqrtf(ss + EPS) * qscale;
#pragma unroll
                    for (int i = 0; i < 8; ++i) o[i] *= sc;
                    v4u wv; wv.x = pk2(o[0], o[1]); wv.y = pk2(o[2], o[3]); wv.z = pk2(o[4], o[5]); wv.w = pk2(o[6], o[7]);
                    *(v4u*)(QKrm + (size_t)r * 4096 + c0) = wv;
                    if (strip < 4) {
                        const int rl = r & 63, mt = rl >> 5, r32 = rl & 31, f = (mt * 4 + (Lp >> 2)) * 2 + ((Lp >> 1) & 1);
                        unsigned char* d = qbase + f * 1024 + r32 * 16 + (Lp & 1) * 8;
                        *(v2u*)(d) = (v2u){wv.x, wv.y}; *(v2u*)(d + 512) = (v2u){wv.z, wv.w};
                    }
                }
                if (strip >= 4) {
                    if (rr & 1) {
#pragma unroll
                        for (int i = 0; i < 8; ++i) pk[i][rr >> 1] = pk2(prev[i], o[i]);
                    } else {
#pragma unroll
                        for (int i = 0; i < 8; ++i) prev[i] = o[i];
                    }
                }
            }
            if (strip >= 4) {
                const int q = (run & 1) * 2 + g, f = ((Lp >> 2) * 2 + (q >> 1)) * 2 + (q & 1);
                unsigned char* d = tbase + f * 1024 + (8 * (Lp & 3)) * 16;
#pragma unroll
                for (int i = 0; i < 8; ++i) {
                    *(v4u*)(d + i * 16) = (v4u){pk[i][0], pk[i][1], pk[i][4], pk[i][5]};
                    *(v4u*)(d + 512 + i * 16) = (v4u){pk[i][2], pk[i][3], pk[i][6], pk[i][7]};
                }
            }
        }
    }
    for (size_t i = (size_t)blockIdx.x * 512 + F.tid; i < (size_t)MR * 64; i += (size_t)F.G * 512) {
        const int r = (int)(i >> 6), e = (int)(i & 63), dir = e >> 5, hv = e & 31;
        const float gb = GATES[(size_t)r * 128 + dir * 64 + hv], ga = GATES[(size_t)r * 128 + dir * 64 + 32 + hv] + dt_bias[e];
        const float sp = fmaxf(ga, 0.f) + log1pf(expf(-fabsf(ga)));
        BG[i] = 1.f / (1.f + expf(-gb)); BG[(size_t)MR * 64 + i] = -expf(a_log[e]) * sp;
    }
}

constexpr int DK_REGION = 17920;
constexpr int TROW = 136;
__device__ __forceinline__ void dk_phase(const Frame& F, const bf16* QKrm, const unsigned char* KT, const unsigned char* VT, const float* BG, unsigned char* ITEMS) {
    LAS unsigned char* reg = F.lds + F.wave * DK_REGION;
    LAS float* Amat = (LAS float*)reg; LAS unsigned char* TW = reg; LAS unsigned char* TU = reg + 64 * TROW;
    LAS float* gamL = (LAS float*)(reg + 17408); LAS float* betaL = gamL + 64;
    for (int it = F.gw; it < NCB * 64; it += F.NGW) {
        int lane_l = F.lane; asm volatile("" : "+v"(lane_l));
        const int lane = lane_l, r32 = lane & 31, hi = lane >> 5;
        const int cb = it >> 6, hv = (it >> 1) & 31, dir = it & 1, hk = hv >> 1;
        unsigned char* item = ITEMS + (size_t)it * ITEM_BYTES;
        const int row0 = cb * 64;
        const float gl = BG[(size_t)MR * 64 + (size_t)(row0 + lane) * 64 + dir * 32 + hv], bl = BG[(size_t)(row0 + lane) * 64 + dir * 32 + hv];
        float gam = gl;
        if (dir == 0) {
#pragma unroll
            for (int o = 1; o < 64; o <<= 1) { const float t = shl_from(gam, lane - o); if (lane >= o) gam += t; }
        } else {
#pragma unroll
            for (int o = 1; o < 64; o <<= 1) { const float t = shl_from(gam, lane + o); if (lane + o < 64) gam += t; }
        }
        const float last = shl_from(gam, dir ? 0 : 63);
        gamL[lane] = gam; betaL[lane] = bl;
        {
            const int w = lane & 31, idx = ((lane >> 5) * 2 + ((w >> 2) & 1)) * 16 + (w & 3) + 4 * (w >> 3);
            float* tab = (float*)(item + ITEM_TAB);
            tab[idx] = __expf(gam); tab[64 + idx] = __expf(last - gam); if (lane == 0) tab[128] = __expf(last);
        }
        LDS_WAIT();
        const bf16* Kb = QKrm + (size_t)row0 * 4096 + 2048 + hk * 128 + 8 * hi;
        const bf16* Qb = QKrm + (size_t)row0 * 4096 + hk * 128 + 8 * hi;
        bf16x8_t Kn[2][8];
#pragma unroll
        for (int mi = 0; mi < 2; ++mi)
#pragma unroll
            for (int ks = 0; ks < 8; ++ks) Kn[mi][ks] = as_frag(*(const v4u*)(Kb + (size_t)(32 * mi + r32) * 4096 + 16 * ks));
        {
            f32x16_t kk[2][2];
#pragma unroll
            for (int mi = 0; mi < 2; ++mi)
#pragma unroll
                for (int ni = 0; ni < 2; ++ni) { kk[mi][ni] = f32x16_t{};
#pragma unroll
                    for (int ks = 0; ks < 8; ++ks) kk[mi][ni] = __builtin_amdgcn_mfma_f32_32x32x16_bf16(Kn[mi][ks], Kn[ni][ks], kk[mi][ni], 0, 0, 0); }
#pragma unroll
            for (int ni = 0; ni < 2; ++ni) { const int s = 32 * ni + r32; const float gs = gamL[s]; const int sp = dir ? 63 - s : s;
#pragma unroll
                for (int mi = 0; mi < 2; ++mi)
#pragma unroll
                    for (int rg = 0; rg < 16; ++rg) { const int r = 32 * mi + crow16(rg, hi); const int rp = dir ? 63 - r : r;
                        const float gr = gamL[r], br = betaL[r];
                        const float v = (sp < rp) ? br * kk[mi][ni][rg] * __expf(gr - gs) : 0.f;
                        Amat[rp * 64 + sp] = v; } }
        }
        asm volatile("" ::: "memory"); __builtin_amdgcn_sched_barrier(0);
        {
            bf16x8_t Qn[2][8];
#pragma unroll
            for (int mi = 0; mi < 2; ++mi)
#pragma unroll
                for (int ks = 0; ks < 8; ++ks) Qn[mi][ks] = as_frag(*(const v4u*)(Qb + (size_t)(32 * mi + r32) * 4096 + 16 * ks));
#pragma unroll
            for (int ri = 0; ri < 2; ++ri) { const int r = 32 * ri + r32; const float gr = gamL[r];
#pragma unroll
                for (int si = 0; si < 2; ++si) { f32x16_t p = f32x16_t{};
#pragma unroll
                    for (int ks = 0; ks < 8; ++ks) p = __builtin_amdgcn_mfma_f32_32x32x16_bf16(Kn[si][ks], Qn[ri][ks], p, 0, 0, 0);
                    float pv[16];
#pragma unroll
                    for (int rg = 0; rg < 16; ++rg) { const int s = 32 * si + crow16(rg, hi); const float gs = gamL[s];
                        const bool ok = dir ? (s >= r) : (s <= r);
                        pv[rg] = ok ? p[rg] * __expf(gr - gs) : 0.f; }
#pragma unroll
                    for (int st = 0; st < 2; ++st) { v4u wv; wv.x = pk2(pv[8 * st + 0], pv[8 * st + 1]); wv.y = pk2(pv[8 * st + 2], pv[8 * st + 3]); wv.z = pk2(pv[8 * st + 4], pv[8 * st + 5]); wv.w = pk2(pv[8 * st + 6], pv[8 * st + 7]);
                        *(v4u*)(item + ITEM_AQK + ((ri * 2 + si) * 2 + st) * 1024 + lane * 16) = wv; } } }
        }
        LDS_WAIT();
        asm volatile("" ::: "memory"); __builtin_amdgcn_sched_barrier(0);
        float t[64];
#pragma unroll
        for (int r = 0; r < 64; ++r) {
            float acc = (lane == r) ? 1.f : 0.f;
#pragma unroll
            for (int s4 = 0; s4 < (r + 3) / 4; ++s4) { const f32x4 a = *(const LAS f32x4*)(Amat + r * 64 + 4 * s4);
                if (4 * s4 + 0 < r) acc -= a.x * t[4 * s4 + 0]; if (4 * s4 + 1 < r) acc -= a.y * t[4 * s4 + 1];
                if (4 * s4 + 2 < r) acc -= a.z * t[4 * s4 + 2]; if (4 * s4 + 3 < r) acc -= a.w * t[4 * s4 + 3]; }
            t[r] = acc;
        }
        asm volatile("" ::: "memory"); __builtin_amdgcn_sched_barrier(0);
        {
            const int c = dir ? 63 - lane : lane; const float bc = betaL[c], wc = bc * __expf(gamL[c]);
            asm volatile("s_waitcnt lgkmcnt(0)" ::: "memory");
#pragma unroll
            for (int rp = 0; rp < 64; ++rp) { const int r = dir ? 63 - rp : rp;
                const unsigned w2 = pk2(t[rp] * wc, t[rp] * bc);
                *(LAS unsigned short*)(TW + r * TROW + c * 2) = (unsigned short)(w2 & 0xffffu);
                *(LAS unsigned short*)(TU + r * TROW + c * 2) = (unsigned short)(w2 >> 16); }
        }
        LDS_WAIT();
        asm volatile("" ::: "memory"); __builtin_amdgcn_sched_barrier(0);
        const unsigned char* ktb = KT + ((size_t)cb * 16 + hk) * 16384;
        const unsigned char* vtb = VT + ((size_t)cb * 32 + hv) * 16384;
#pragma unroll
        for (int mt = 0; mt < 2; ++mt) {
            bf16x8_t tb[2][2];
#pragma unroll
            for (int tt = 0; tt < 2; ++tt)
#pragma unroll
                for (int s = 0; s < 2; ++s) { const LAS unsigned char* p = TW + (32 * mt + r32) * TROW + (32 * tt + 16 * s + 4 * hi) * 2;
                    const v2u lo = *(const LAS v2u*)p, hi2 = *(const LAS v2u*)(p + 16); tb[tt][s] = as_frag((v4u){lo.x, lo.y, hi2.x, hi2.y}); }
            bf16x8_t gf[16];
#pragma unroll
            for (int k = 0; k < 16; ++k) gf[k] = as_frag(*(const v4u*)(ktb + k * 1024 + lane * 16));
            asm volatile("s_waitcnt vmcnt(0)" ::: "memory"); __builtin_amdgcn_sched_barrier(0);
#pragma unroll
            for (int dt = 0; dt < 4; ++dt) { f32x16_t acc = f32x16_t{};
#pragma unroll
                for (int tt = 0; tt < 2; ++tt)
#pragma unroll
                    for (int s = 0; s < 2; ++s) { const bf16x8_t a = gf[(dt * 2 + tt) * 2 + s];
                        acc = __builtin_amdgcn_mfma_f32_32x32x16_bf16(a, tb[tt][s], acc, 0, 0, 0); }
#pragma unroll
                for (int st = 0; st < 2; ++st) { v4u wv; wv.x = pk2(acc[8 * st + 0], acc[8 * st + 1]); wv.y = pk2(acc[8 * st + 2], acc[8 * st + 3]); wv.z = pk2(acc[8 * st + 4], acc[8 * st + 5]); wv.w = pk2(acc[8 * st + 6], acc[8 * st + 7]);
                    *(v4u*)(item + ITEM_W + ((mt * 4 + dt) * 2 + st) * 1024 + lane * 16) = wv; } }
            bf16x8_t ta[2][2];
#pragma unroll
            for (int tt = 0; tt < 2; ++tt)
#pragma unroll
                for (int s = 0; s < 2; ++s) { const LAS unsigned char* p = TU + (32 * mt + r32) * TROW + (32 * tt + 16 * s + 4 * hi) * 2;
                    const v2u lo = *(const LAS v2u*)p, hi2 = *(const LAS v2u*)(p + 16); ta[tt][s] = as_frag((v4u){lo.x, lo.y, hi2.x, hi2.y}); }
#pragma unroll
            for (int k = 0; k < 16; ++k) gf[k] = as_frag(*(const v4u*)(vtb + k * 1024 + lane * 16));
            asm volatile("s_waitcnt vmcnt(0)" ::: "memory"); __builtin_amdgcn_sched_barrier(0);
#pragma unroll
            for (int vt = 0; vt < 4; ++vt) { f32x16_t acc = f32x16_t{};
#pragma unroll
                for (int tt = 0; tt < 2; ++tt)
#pragma unroll
                    for (int s = 0; s < 2; ++s) { const bf16x8_t b = gf[(vt * 2 + tt) * 2 + s];
                        acc = __builtin_amdgcn_mfma_f32_32x32x16_bf16(ta[tt][s], b, acc, 0, 0, 0); }
                v4u w0, w1; w0.x = pk2(acc[0], acc[1]); w0.y = pk2(acc[2], acc[3]); w0.z = pk2(acc[4], acc[5]); w0.w = pk2(acc[6], acc[7]);
                w1.x = pk2(acc[8], acc[9]); w1.y = pk2(acc[10], acc[11]); w1.z = pk2(acc[12], acc[13]); w1.w = pk2(acc[14], acc[15]);
                unsigned char* d = item + ITEM_U + (vt * 2 + mt) * 2048 + lane * 32;
                *(v4u*)d = w0; *(v4u*)(d + 16) = w1; }
        }
        LDS_WAIT();
    }
}

constexpr int ST_W = 0, ST_QF = 16384, ST_AQK = 32768, ST_KT = 40960, ST_U = 57344, ST_TAB = 61440, ST_BYTES = 62464;
constexpr int DS_SBUF = 2 * ST_BYTES, DS_XBUF = DS_SBUF + 2 * 8192, DS_OBUF = DS_XBUF + 2 * 4096, DS_END = DS_OBUF + 2 * 4096;
#define DS_BAR() asm volatile("s_waitcnt vmcnt(0) lgkmcnt(0)\n\ts_barrier" ::: "memory")
#define DS_CB(pc) (dir ? ((pc) < 4 ? 3 - (pc) : 263 - (pc)) : (pc))
#define DS_LD4(bank, base) do { _Pragma("unroll") for (int i_ = 0; i_ < 4; ++i_) bank[i_] = as_frag(*(const LAS v4u*)((base) + i_ * 1024 + lane * 16)); } while (0)
#define DS_WAITL(n) do { asm volatile("s_waitcnt lgkmcnt(" #n ")" ::: "memory"); __builtin_amdgcn_sched_barrier(0); } while (0)
#define DS_SB() __builtin_amdgcn_sched_barrier(0)
#define DS_MM4(acc, bank, bop, o) do { _Pragma("unroll") for (int k_ = 0; k_ < 4; ++k_) acc = __builtin_amdgcn_mfma_f32_32x32x16_bf16(bank[k_], bop[(o) + k_], acc, 0, 0, 0); } while (0)
__device__ __forceinline__ void ds_role_state(LAS unsigned char* lds, int lane_in) {
    int lane = lane_in; asm volatile("" : "+v"(lane));
    const int hi = lane >> 5;
    f32x16_t Sacc[4]; bf16x8_t sb[8];
#pragma unroll
    for (int d = 0; d < 4; ++d) Sacc[d] = f32x16_t{};
#pragma unroll
    for (int k = 0; k < 8; ++k) { sb[k] = bf16x8_t{}; *(LAS v4u*)(lds + DS_SBUF + k * 1024 + lane * 16) = (v4u){0u, 0u, 0u, 0u}; }
    DS_BAR();
#pragma unroll 1
    for (int pc = 0; pc < NCB; ++pc) {
        const int bsel = pc & 1; LAS unsigned char* st = lds + bsel * ST_BYTES;
        const LAS float* tab = (const LAS float*)(st + ST_TAB);
        bf16x8_t f0[4], f1[4], vy[4];
        float el;
        {
            f32x16_t ws0 = f32x16_t{}, ws1 = f32x16_t{};
            DS_LD4(f0, st + ST_W); DS_SB();
            DS_LD4(f1, st + ST_W + 4096); DS_WAITL(4); DS_MM4(ws0, f0, sb, 0); DS_SB();
            DS_LD4(f0, st + ST_W + 8192); DS_WAITL(4); DS_MM4(ws0, f1, sb, 4); DS_SB();
            DS_LD4(f1, st + ST_W + 12288); DS_WAITL(4); DS_MM4(ws1, f0, sb, 0); DS_SB();
            DS_WAITL(0); DS_MM4(ws1, f1, sb, 4); DS_SB();
            DS_LD4(f0, st + ST_KT); DS_SB();
            el = tab[128];
#pragma unroll
            for (int mt = 0; mt < 2; ++mt) {
                const LAS v4u* up = (const LAS v4u*)(st + ST_U + mt * 2048 + lane * 32); const v4u u0 = up[0], u1 = up[1];
                const unsigned uu[8] = {u0.x, u0.y, u0.z, u0.w, u1.x, u1.y, u1.z, u1.w};
                float vn[16], vs2[16];
                const LAS f32x4* elg4 = (const LAS f32x4*)(tab + 64 + (mt * 2 + hi) * 16);
#pragma unroll
                for (int q4 = 0; q4 < 4; ++q4) { const f32x4 e = elg4[q4]; const float w0 = mt ? ws1[4 * q4 + 0] : ws0[4 * q4 + 0], w1 = mt ? ws1[4 * q4 + 1] : ws0[4 * q4 + 1], w2 = mt ? ws1[4 * q4 + 2] : ws0[4 * q4 + 2], w3 = mt ? ws1[4 * q4 + 3] : ws0[4 * q4 + 3];
                    vn[4 * q4 + 0] = bflo(uu[2 * q4]) - w0; vn[4 * q4 + 1] = bfhi(uu[2 * q4]) - w1; vn[4 * q4 + 2] = bflo(uu[2 * q4 + 1]) - w2; vn[4 * q4 + 3] = bfhi(uu[2 * q4 + 1]) - w3;
                    vs2[4 * q4 + 0] = vn[4 * q4 + 0] * e.x; vs2[4 * q4 + 1] = vn[4 * q4 + 1] * e.y; vs2[4 * q4 + 2] = vn[4 * q4 + 2] * e.z; vs2[4 * q4 + 3] = vn[4 * q4 + 3] * e.w; }
#pragma unroll
                for (int s = 0; s < 2; ++s) {
                    v4u xv; xv.x = pk2(vn[8 * s + 0], vn[8 * s + 1]); xv.y = pk2(vn[8 * s + 2], vn[8 * s + 3]); xv.z = pk2(vn[8 * s + 4], vn[8 * s + 5]); xv.w = pk2(vn[8 * s + 6], vn[8 * s + 7]);
                    *(LAS v4u*)(lds + DS_XBUF + bsel * 4096 + (mt * 2 + s) * 1024 + lane * 16) = xv;
                    v4u yv; yv.x = pk2(vs2[8 * s + 0], vs2[8 * s + 1]); yv.y = pk2(vs2[8 * s + 2], vs2[8 * s + 3]); yv.z = pk2(vs2[8 * s + 4], vs2[8 * s + 5]); yv.w = pk2(vs2[8 * s + 6], vs2[8 * s + 7]);
                    vy[mt * 2 + s] = as_frag(yv); }
            }
        }
        DS_SB();
        DS_LD4(f1, st + ST_KT + 4096); DS_WAITL(4);
        Sacc[0] = Sacc[0] * el; DS_MM4(Sacc[0], f0, vy, 0); DS_SB();
        DS_LD4(f0, st + ST_KT + 8192); DS_WAITL(4);
        Sacc[1] = Sacc[1] * el; DS_MM4(Sacc[1], f1, vy, 0); DS_SB();
        DS_LD4(f1, st + ST_KT + 12288); DS_WAITL(4);
        Sacc[2] = Sacc[2] * el; DS_MM4(Sacc[2], f0, vy, 0); DS_SB();
        DS_WAITL(0);
        Sacc[3] = Sacc[3] * el; DS_MM4(Sacc[3], f1, vy, 0); DS_SB();
#pragma unroll
        for (int d = 0; d < 4; ++d)
#pragma unroll
            for (int s = 0; s < 2; ++s) { v4u sv; sv.x = pk2(Sacc[d][8 * s + 0], Sacc[d][8 * s + 1]); sv.y = pk2(Sacc[d][8 * s + 2], Sacc[d][8 * s + 3]); sv.z = pk2(Sacc[d][8 * s + 4], Sacc[d][8 * s + 5]); sv.w = pk2(Sacc[d][8 * s + 6], Sacc[d][8 * s + 7]);
                sb[d * 2 + s] = as_frag(sv);
                *(LAS v4u*)(lds + DS_SBUF + (bsel ^ 1) * 8192 + (d * 2 + s) * 1024 + lane * 16) = sv; }
        DS_BAR();
    }
    DS_BAR();
}
__device__ __forceinline__ void ds_role_out(LAS unsigned char* lds, int lane_in) {
    int lane = lane_in; asm volatile("" : "+v"(lane));
    const int hi = lane >> 5;
    f32x16_t po0 = f32x16_t{}, po1 = f32x16_t{}; bf16x8_t aq[8];
#pragma unroll
    for (int k = 0; k < 8; ++k) aq[k] = bf16x8_t{};
    DS_BAR();
#pragma unroll 1
    for (int pc = 0; pc <= NCB; ++pc) {
        const int bsel = pc & 1; LAS unsigned char* st = lds + bsel * ST_BYTES;
        if (pc > 0) {
            bf16x8_t vx[4];
            DS_LD4(vx, lds + DS_XBUF + (bsel ^ 1) * 4096); DS_WAITL(0);
            DS_MM4(po0, aq, vx, 0);
#pragma unroll
            for (int k = 0; k < 4; ++k) po1 = __builtin_amdgcn_mfma_f32_32x32x16_bf16(aq[4 + k], vx[k], po1, 0, 0, 0);
            DS_SB();
            LAS unsigned short* ob = (LAS unsigned short*)(lds + DS_OBUF + bsel * 4096);
#pragma unroll
            for (int rg = 0; rg < 16; rg += 2) { const unsigned w2 = pk2(po0[rg], po0[rg + 1]), w3 = pk2(po1[rg], po1[rg + 1]);
                ob[(crow16(rg, hi)) * 32 + (lane & 31)] = (unsigned short)(w2 & 0xffffu); ob[(crow16(rg + 1, hi)) * 32 + (lane & 31)] = (unsigned short)(w2 >> 16);
                ob[(32 + crow16(rg, hi)) * 32 + (lane & 31)] = (unsigned short)(w3 & 0xffffu); ob[(32 + crow16(rg + 1, hi)) * 32 + (lane & 31)] = (unsigned short)(w3 >> 16); }
        }
        if (pc < NCB) {
            const LAS float* tab = (const LAS float*)(st + ST_TAB);
            bf16x8_t sf[8], f0[4], f1[4];
#pragma unroll
            for (int k = 0; k < 8; ++k) sf[k] = as_frag(*(const LAS v4u*)(lds + DS_SBUF + bsel * 8192 + k * 1024 + lane * 16));
            DS_LD4(f0, st + ST_QF); DS_SB();
            po0 = f32x16_t{}; po1 = f32x16_t{};
            DS_LD4(f1, st + ST_QF + 4096); DS_WAITL(4); DS_MM4(po0, f0, sf, 0); DS_SB();
            DS_LD4(f0, st + ST_QF + 8192); DS_WAITL(4); DS_MM4(po0, f1, sf, 4); DS_SB();
            DS_LD4(f1, st + ST_QF + 12288); DS_WAITL(4); DS_MM4(po1, f0, sf, 0); DS_SB();
            DS_WAITL(0); DS_MM4(po1, f1, sf, 4); DS_SB();
#pragma unroll
            for (int k = 0; k < 8; ++k) aq[k] = as_frag(*(const LAS v4u*)(st + ST_AQK + k * 1024 + lane * 16));
            const LAS f32x4* eg40 = (const LAS f32x4*)(tab + (0 * 2 + hi) * 16); const LAS f32x4* eg41 = (const LAS f32x4*)(tab + (1 * 2 + hi) * 16);
#pragma unroll
            for (int q4 = 0; q4 < 4; ++q4) { const f32x4 g0 = eg40[q4], g1 = eg41[q4];
                po0[4 * q4 + 0] *= g0.x; po0[4 * q4 + 1] *= g0.y; po0[4 * q4 + 2] *= g0.z; po0[4 * q4 + 3] *= g0.w;
                po1[4 * q4 + 0] *= g1.x; po1[4 * q4 + 1] *= g1.y; po1[4 * q4 + 2] *= g1.z; po1[4 * q4 + 3] *= g1.w; }
        }
        DS_BAR();
    }
}
__device__ __forceinline__ void ds_role_load(LAS unsigned char* lds, int lt, const unsigned char* ITEMS, const unsigned char* QF, const unsigned char* KT, bf16* Od, int hv, int hk, int dir, int vs) {
    const int lw = __builtin_amdgcn_readfirstlane(lt >> 6), g = lw >> 1, wg = lw & 1, ll = lt & 63;
    v4u tr[31];
#define DS_ISSUE(pc) do { const int cb_ = DS_CB(pc); const unsigned char* item_ = ITEMS + ((size_t)(cb_ * 32 + hv) * 2 + dir) * ITEM_BYTES + (size_t)wg * 1024 + ll * 16; \
        const unsigned char* qf_ = QF + ((size_t)cb_ * 16 + hk) * 16384 + (size_t)wg * 1024 + ll * 16; const unsigned char* kt_ = KT + ((size_t)cb_ * 16 + hk) * 16384 + (size_t)wg * 1024 + ll * 16; \
        _Pragma("unroll") for (int k_ = 0; k_ < 8; ++k_) tr[k_] = *(const v4u*)(item_ + k_ * 2048); \
        _Pragma("unroll") for (int k_ = 0; k_ < 8; ++k_) tr[8 + k_] = *(const v4u*)(qf_ + k_ * 2048); \
        _Pragma("unroll") for (int k_ = 0; k_ < 4; ++k_) tr[16 + k_] = *(const v4u*)(item_ + ITEM_AQK + k_ * 2048); \
        _Pragma("unroll") for (int k_ = 0; k_ < 8; ++k_) tr[20 + k_] = *(const v4u*)(kt_ + k_ * 2048); \
        _Pragma("unroll") for (int k_ = 0; k_ < 2; ++k_) tr[28 + k_] = *(const v4u*)(item_ + ITEM_U + vs * 4096 + k_ * 2048); \
        if (wg == 0) tr[30] = *(const v4u*)(item_ + ITEM_TAB); } while (0)
#define DS_COMMIT(buf) do { LAS unsigned char* d_ = lds + (buf) * ST_BYTES + wg * 1024 + ll * 16; \
        _Pragma("unroll") for (int k_ = 0; k_ < 30; ++k_) *(LAS v4u*)(d_ + k_ * 2048) = tr[k_]; \
        if (wg == 0) *(LAS v4u*)(d_ + 61440) = tr[30]; } while (0)
#define DS_BAR_L() asm volatile("s_waitcnt lgkmcnt(0)\n\ts_barrier" ::: "memory")
    int ncs;
    if (g == 0) { DS_ISSUE(0); DS_COMMIT(0); DS_ISSUE(3); ncs = 2; }
    else if (g == 1) { DS_ISSUE(1); ncs = 0; }
    else { DS_ISSUE(2); ncs = 1; }
    DS_BAR_L();
#pragma unroll 1
    for (int pc = 0; pc <= NCB; ++pc) {
        if (pc == ncs) {
            if (pc + 1 < NCB) DS_COMMIT((pc + 1) & 1);
            if (pc + 4 < NCB) DS_ISSUE(pc + 4);
            ncs += 3;
        }
        if (pc >= 2 && (pc % 3) == g) {
            const int cbo = DS_CB(pc - 2);
#pragma unroll
            for (int k = 0; k < 2; ++k) { const int f = wg + 2 * k, rr = f * 16 + (ll >> 2), pz = ll & 3;
                const v4u v = *(const LAS v4u*)(lds + DS_OBUF + ((pc & 1) ^ 1) * 4096 + rr * 64 + pz * 16);
                *(v4u*)(Od + (size_t)(cbo * 64 + rr) * 4096 + pz * 8) = v; }
        }
        DS_BAR_L();
    }
    if (g == 0) {
        const int cbo = DS_CB(NCB - 1);
#pragma unroll
        for (int k = 0; k < 2; ++k) { const int f = wg + 2 * k, rr = f * 16 + (ll >> 2), pz = ll & 3;
            const v4u v = *(const LAS v4u*)(lds + DS_OBUF + (NCB & 1) * 4096 + rr * 64 + pz * 16);
            *(v4u*)(Od + (size_t)(cbo * 64 + rr) * 4096 + pz * 8) = v; }
    }
#undef DS_ISSUE
#undef DS_COMMIT
#undef DS_BAR_L
}
__device__ __forceinline__ void ds_phase(const Frame& F, const unsigned char* ITEMS, const unsigned char* QF, const unsigned char* KT, bf16* O) {
    for (int b = blockIdx.x; b < 256; b += F.G) {
        const int hk_dir = (b & 7) * 4 + ((b >> 3) >> 3), sub = (b >> 3) & 7;
        const int hk = hk_dir >> 1, dir = hk_dir & 1, hv = 2 * hk + (sub >> 2), vs = sub & 3;
        bf16* Od = O + (size_t)dir * MR * 4096 + hv * 128 + vs * 32;
        if (F.wave == 0) ds_role_state(F.lds, F.lane);
        else if (F.wave == 1) ds_role_out(F.lds, F.lane);
        else ds_role_load(F.lds, F.tid - 128, ITEMS, QF, KT, Od, hv, hk, dir, vs);
        DS_BAR();
    }
}
#undef DS_BAR
#undef DS_CB
#undef DS_LD4
#undef DS_WAITL
#undef DS_SB
#undef DS_MM4

__device__ __forceinline__ void dnout2_phase(const Frame& F, const bf16* O, const bf16* Z, bf16* HM, const float* gn) {
    const int d0 = (F.lane & 15) * 8;
    float g[8];
#pragma unroll
    for (int i = 0; i < 8; ++i) g[i] = gn[d0 + i];
    for (int it = F.gw; it < MR * 8; it += F.NGW) {
        const int r = it >> 3, c0 = (it & 7) * 512 + F.lane * 8;
        const Row8 a = unpack8(*(const v4u*)(O + (size_t)r * 4096 + c0)), bq = unpack8(*(const v4u*)(O + (size_t)MR * 4096 + (size_t)r * 4096 + c0));
        const Row8 z = unpack8(*(const v4u*)(Z + (size_t)r * 4096 + c0));
        float o[8]; float ss = 0.f;
#pragma unroll
        for (int i = 0; i < 8; ++i) { o[i] = a.v[i] + bq.v[i]; ss += o[i] * o[i]; }
        ss += shx(ss, 1, F.lane); ss += shx(ss, 2, F.lane); ss += shx(ss, 4, F.lane); ss += shx(ss, 8, F.lane);
        const float rs = rsqrtf(ss * (1.f / 128.f) + EPS);
#pragma unroll
        for (int i = 0; i < 8; ++i) o[i] = o[i] * rs * g[i] * siluf(z.v[i]);
        v4u w; w.x = pk2(o[0], o[1]); w.y = pk2(o[2], o[3]); w.z = pk2(o[4], o[5]); w.w = pk2(o[6], o[7]);
        *(v4u*)(HM + (size_t)r * 4096 + c0) = w;
    }
}
#ifndef ATT_SD
#define ATT_SD 1
#endif

__device__ __forceinline__ void diffattn_phase(const Frame& F, const bf16* QKV, float* OA) {
    char* lds = (char*)(unsigned char*)F.lds;
    const int c = blockIdx.x;
    for (int i = 0; ; ++i) {
        int combo, row0, nt;
        if (F.G == 256) { if (i < 4) { combo = 2 * i + ((c & 7) >> 2); row0 = CTXN + 128 * (((c & 3) << 5) + (c >> 3)); nt = 260; } else if (i == 4 && c < 16) { combo = c >> 1; row0 = 128 * (c & 1); nt = 4; } else break; }
        else { const int u = i * F.G + c; if (u >= 8 * 130) break; combo = u / 130; const int hp = u % 130; row0 = 128 * hp; nt = hp < 2 ? 4 : 260; }
        const int h = combo >> 1, m = combo & 1;
        const bf16* Qb = QKV + (size_t)row0 * ATTN_IN + h * 256 + m * 128;
        const bf16* Kh = QKV + 1024 + h * 256 + m * 128;
        const bf16* Vh = QKV + 2048 + h * 256;
        float* Ob = OA + (size_t)row0 * 2048 + h * 512 + m * 256;
        att::attn_pair_body<ATTN_IN, ATTN_IN, 2048>(Qb, Kh, Vh, Ob, nt, lds, F.tid);
    }
}
__device__ __forceinline__ void swa_phase(const Frame& F, const bf16* QKV, float* OB, const float* sink) {
    char* lds = (char*)(unsigned char*)F.lds;
    for (int u = blockIdx.x; u < 8 * 65; u += F.G) {
        const int hq = u / 65, p = u % 65, kv = hq >> 2;
        const bf16* Qb = QKV + (size_t)(p * 256) * ATTN_IN + 3072 + hq * 128;
        const bf16* Kh = QKV + 4096 + kv * 128;
        const bf16* Vh = QKV + 4352 + kv * 128;
        float* Ob = OB + (size_t)(p * 256) * 1024 + hq * 128;
        int NT = 4, wb = 0, q0 = 0;
        if (p > 0) { q0 = (p - 1) * 256; const int lo = q0 - 128 < 0 ? 0 : q0 - 128, hi = q0 + 384 > SEQ ? SEQ : q0 + 384; wb = CTXN + lo; NT = 4 + (hi - lo) / 64; }
        att::attn_body<true, ATTN_IN, ATTN_IN, 1024, 1>(Qb, Kh, Vh, Ob, NT, wb, q0, sink[hq] * 1.4426950408889634f, lds, F.tid);
    }
}

constexpr int SLOTS = 11, N_PHASES = 2 + DEPTH * SLOTS;
#ifndef REP_GIN
#define REP_GIN 1
#endif
#ifndef REP_GUP
#define REP_GUP 1
#endif
#ifndef REP_GDN
#define REP_GDN 1
#endif
#ifndef REP_GOUT
#define REP_GOUT 1
#endif
#ifndef REP_DK
#define REP_DK 1
#endif
#ifndef REP_DS
#define REP_DS 1
#endif
#ifndef REP_ATT
#define REP_ATT 1
#endif
#ifndef REP_SWA
#define REP_SWA 1
#endif
#ifndef REP_THIN
#define REP_THIN 1
#endif
#ifndef REP_CONV
#define REP_CONV REP_THIN
#endif
#ifndef REP_DNCONV
#define REP_DNCONV REP_THIN
#endif
__global__ void __launch_bounds__(NWAVES * 64, 2) fwd_kernel(Args args) {
    extern __shared__ __attribute__((aligned(16))) unsigned char lds_raw[];
    Frame F;
    F.lds = (LAS unsigned char*)lds_raw;
    F.tid = threadIdx.x; F.lane = F.tid & 63; F.wave = __builtin_amdgcn_readfirstlane(F.tid >> 6);
    F.G = gridDim.x; F.gw = blockIdx.x * NWAVES + F.wave; F.NGW = F.G * NWAVES;
    volatile LAS unsigned* MISC = (volatile LAS unsigned*)(F.lds + MISC_OFF);
    if (F.tid < 64) MISC[F.tid] = 0u;
    if (F.tid < 24) *(LAS unsigned long long*)(F.lds + ARGT_OFF + F.tid * 8) = (unsigned long long)(F.tid < 23 ? (const void*)args.in[F.tid] : (const void*)args.out);
    __syncthreads();
    unsigned char* ws = args.ws;
    XcdBarrier bar; bar.bar = (unsigned*)(ws + WS_CTL) + CW_BAR; bar.x = 0; bar.st = nullptr;
    if (args.use_bar) bar = xcd_barrier_post((unsigned*)(ws + WS_CTL) + CW_BAR, MISC + 8);
    const int lo = args.ph_lo, hi = args.ph_hi;
#define IN(k) (lo <= (k) && (k) < hi)
#define RELAUNDER() do { int t_ = threadIdx.x; asm volatile("" : "+v"(t_)); F.tid = t_; F.lane = t_ & 63; F.wave = __builtin_amdgcn_readfirstlane(t_ >> 6); F.gw = blockIdx.x * NWAVES + F.wave; } while (0)
#define SEAM(k) do { if ((k) + 1 < hi) xcd_barrier(bar); } while (0)

    float* X = (float*)(ws + WS_X); bf16* H = (bf16*)(ws + WS_H);
    const float* MOD = (const float*)(ws + WS_MOD);
    bf16* WIN = (bf16*)(ws + WS_WIN); bf16* WOUT = (bf16*)(ws + WS_WOUT); bf16* WUP = (bf16*)(ws + WS_WUP); bf16* WDN = (bf16*)(ws + WS_WDN);

    if (IN(0)) { RELAUNDER(); p0_prologue(F, ws); SEAM(0); }

    for (int layer = 0; layer < DEPTH; ++layer) {
        const int pb = 1 + layer * SLOTS, li = layer >> 1;
        const float* mod_lat = MOD + (size_t)(layer * 2 + 0) * 12288; const float* mod_ctx = MOD + (size_t)(layer * 2 + 1) * 12288;
        if (IN(pb + 0)) { RELAUNDER();
            for (int rep_ = 0; rep_ < REP_THIN; ++rep_) { norm_phase(F, X, H, AIN(I_N1G) + layer * DM, mod_lat, mod_ctx, 0, (const float*)(ws + WS_P), layer > 0 ? FFH / 256 : 0, MOD + (size_t)((layer - 1) * 2 + 1) * 12288 + 5 * 2048); }
            for (int rep_ = 0; rep_ < REP_CONV; ++rep_) { convert_layer_weights(F, ws, layer); }
            SEAM(pb + 0); }
        if ((layer & 1) == 0) {
            bf16* QKV = (bf16*)(ws + WS_QKV); float* OA = (float*)(ws + WS_OA); float* OB = (float*)(ws + WS_OB); bf16* HM = (bf16*)(ws + WS_HM_ATT);
            if (IN(pb + 1)) { RELAUNDER();
                pg8::Gemm g{H, WIN, MR, ATTN_IN, DM, DM}; pg8::StaticOrder S; S.init(MR, ATTN_IN, F.G, (int)blockIdx.x);
                pg8::EpiQKV E{QKV, ATTN_IN, (const float*)(ws + WS_ROPE)};
                pg8::gemm_phase<pg8::EpiQKV, pg8::StaticOrder, true, true>(F.lds, g, S, E, F.tid);
                SEAM(pb + 1);
            }
            if (IN(pb + 2)) { RELAUNDER();
                for (int rep_ = 0; rep_ < REP_ATT; ++rep_) { diffattn_phase(F, QKV, OA); }
                for (int rep_ = 0; rep_ < REP_SWA; ++rep_) { swa_phase(F, QKV, OB, AIN(I_SINK) + li * 8); }
                SEAM(pb + 2); }
            if (IN(pb + 3)) { RELAUNDER();
                for (int rep_ = 0; rep_ < REP_THIN; ++rep_) { merge_phase(F, OA, OB, HM, AIN(I_SUBLN) + li * 256, ((const float*)(ws + WS_LAM))[li], li == 0 ? 0.2f : 0.4707130183435842f); }
                SEAM(pb + 3); }
            if (IN(pb + 4)) { RELAUNDER();
                { pg8::Gemm g{HM + (size_t)CTXN * DM, WOUT, SEQ, DM, DM, DM}; pg8::StaticOrder S; S.init(SEQ, DM, F.G, (int)blockIdx.x);
                  pg8::EpiResid E{X + (size_t)CTXN * DM, DM, mod_lat + 2 * 2048, mod_lat + 2 * 2048};
                  pg8::gemm_phase<pg8::EpiResid, pg8::StaticOrder, true, true>(F.lds, g, S, E, F.tid); }
                RELAUNDER();
                { int ksl = 256; asm volatile("" : "+s"(ksl)); pg8::Gemm g{HM, WOUT, CTXN, DM, ksl, DM}; pg8::SliceOrder S; S.init(DM, DM / 256, 256, F.G, (int)blockIdx.x);
                  pg8::EpiPart E{(float*)(ws + WS_P), DM};
                  pg8::gemm_phase<pg8::EpiPart, pg8::SliceOrder, true, true>(F.lds, g, S, E, F.tid); }
                SEAM(pb + 4);
            }
        } else {
            bf16* RAW = (bf16*)(ws + WS_RAW); bf16* Z = (bf16*)(ws + WS_Z); float* GATES = (float*)(ws + WS_GATES); bf16* QKRM = (bf16*)(ws + WS_QKRM);
            float* BG = (float*)(ws + WS_BG); bf16* O = (bf16*)(ws + WS_O); bf16* HM = (bf16*)(ws + WS_HM_DN);
            unsigned char* QF = ws + WS_QF; unsigned char* KT = ws + WS_KT; unsigned char* VT = ws + WS_VT; unsigned char* ITEMS = ws + WS_ITEMS;
            if (IN(pb + 1)) { RELAUNDER();
                pg8::Gemm g{H, WIN, MR, DN_INP, DM, DM}; pg8::StaticOrder S; S.init(MR, DN_INP, F.G, (int)blockIdx.x);
                pg8::EpiDnIn E{RAW, Z, GATES};
                pg8::gemm_phase<pg8::EpiDnIn, pg8::StaticOrder, true, true>(F.lds, g, S, E, F.tid);
                SEAM(pb + 1);
            }
            if (IN(pb + 2)) { RELAUNDER();
                for (int rep_ = 0; rep_ < REP_DNCONV; ++rep_) { dnconv2_phase(F, RAW, QKRM, QF, KT, VT, AIN(I_DCONV) + (size_t)li * 3 * 8192, GATES, BG, AIN(I_DALOG) + li * 64, AIN(I_DDT) + li * 64); }
                SEAM(pb + 2); }
            if (IN(pb + 3)) { RELAUNDER(); for (int rep_ = 0; rep_ < REP_DK; ++rep_) { dk_phase(F, QKRM, KT, VT, BG, ITEMS); } SEAM(pb + 3); }
            if (IN(pb + 4)) { RELAUNDER(); for (int rep_ = 0; rep_ < REP_DS; ++rep_) { ds_phase(F, ITEMS, QF, KT, O); } SEAM(pb + 4); }
            if (IN(pb + 5)) { RELAUNDER(); for (int rep_ = 0; rep_ < REP_THIN; ++rep_) { dnout2_phase(F, O, Z, HM, AIN(I_DNG) + li * 128); } SEAM(pb + 5); }
            if (IN(pb + 6)) { RELAUNDER();
                { pg8::Gemm g{HM + (size_t)CTXN * 4096, WOUT, SEQ, DM, 4096, 4096}; pg8::StaticOrder S; S.init(SEQ, DM, F.G, (int)blockIdx.x);
                  pg8::EpiResid E{X + (size_t)CTXN * DM, DM, mod_lat + 2 * 2048, mod_lat + 2 * 2048};
                  pg8::gemm_phase<pg8::EpiResid, pg8::StaticOrder, true, true>(F.lds, g, S, E, F.tid); }
                RELAUNDER();
                if (layer != DEPTH - 1) { int ksl = 256; asm volatile("" : "+s"(ksl)); pg8::Gemm g{HM, WOUT, CTXN, DM, ksl, 4096}; pg8::SliceOrder S; S.init(DM, 4096 / 256, 256, F.G, (int)blockIdx.x);
                  pg8::EpiPart E{(float*)(ws + WS_P), DM};
                  pg8::gemm_phase<pg8::EpiPart, pg8::SliceOrder, true, true>(F.lds, g, S, E, F.tid); }
                SEAM(pb + 6);
            }
        }
        if (IN(pb + 7)) { RELAUNDER(); for (int rep_ = 0; rep_ < REP_THIN; ++rep_) { norm_phase(F, X, H, AIN(I_N2G) + layer * DM, mod_lat, mod_ctx, 3, (const float*)(ws + WS_P), layer == DEPTH - 1 ? 0 : ((layer & 1) ? 4096 / 256 : DM / 256), mod_ctx + 2 * 2048); } SEAM(pb + 7); }
        if (IN(pb + 8)) { RELAUNDER();
            const int mofs = (layer == DEPTH - 1) ? CTXN : 0;
            pg8::Gemm g{H + (size_t)mofs * DM, WUP, MR - mofs, FFU, DM, DM}; pg8::StaticOrder S; S.init(MR - mofs, FFU, F.G, (int)blockIdx.x);
            pg8::EpiBf16 E{(bf16*)(ws + WS_U) + (size_t)mofs * FFU, FFU};
            pg8::gemm_phase<pg8::EpiBf16, pg8::StaticOrder, true, true>(F.lds, g, S, E, F.tid);
            SEAM(pb + 8);
        }
        if (IN(pb + 9)) { RELAUNDER(); for (int rep_ = 0; rep_ < REP_THIN; ++rep_) { convgate_phase(F, (const bf16*)(ws + WS_U), (bf16*)(ws + WS_A2), AIN(I_FCONV) + (size_t)layer * 3 * FFU, layer == DEPTH - 1 ? CTXN / 32 : 0); } SEAM(pb + 9); }
        if (IN(pb + 10)) { RELAUNDER();
            { pg8::Gemm g{(const bf16*)(ws + WS_A2) + (size_t)CTXN * FFH, WDN, SEQ, DM, FFH, FFH}; pg8::StaticOrder S; S.init(SEQ, DM, F.G, (int)blockIdx.x);
              pg8::EpiResid E{X + (size_t)CTXN * DM, DM, mod_lat + 5 * 2048, mod_lat + 5 * 2048};
              pg8::gemm_phase<pg8::EpiResid, pg8::StaticOrder, true, true>(F.lds, g, S, E, F.tid); }
            RELAUNDER();
            if (layer != DEPTH - 1) { int ksl = 256; asm volatile("" : "+s"(ksl)); pg8::Gemm g{(const bf16*)(ws + WS_A2), WDN, CTXN, DM, ksl, FFH}; pg8::SliceOrder S; S.init(DM, FFH / 256, 256, F.G, (int)blockIdx.x);
              pg8::EpiPart E{(float*)(ws + WS_P), DM};
              pg8::gemm_phase<pg8::EpiPart, pg8::SliceOrder, true, true>(F.lds, g, S, E, F.tid); }
            SEAM(pb + 10);
        }
    }
    if (IN(N_PHASES - 1)) { RELAUNDER(); final_phase(F, X, (float*)AIN(23), AIN(I_FING)); }
#undef IN
#undef SEAM
#undef RELAUNDER
}

#ifndef MK_ONE_LAUNCH
#define MK_ONE_LAUNCH 1
#endif
extern "C" void kernel_launch(void* const* d_in, const int* in_sizes, int n_in, void* d_out, int out_size, void* d_ws, size_t ws_size, hipStream_t stream) {
    static int grid = 0;
    if (grid == 0) {
        if (n_in != 23 || out_size != SEQ * DM || ws_size < WS_END) { fprintf(stderr, "kernel_launch: unexpected problem: n_in %d out %d ws %zu (need %zu)\n", n_in, out_size, ws_size, (size_t)WS_END); grid = -1; return; }
        int dev = 0, cus = 0, per_cu = 0;
        if (hipGetDevice(&dev) != hipSuccess || hipDeviceGetAttribute(&cus, hipDeviceAttributeMultiprocessorCount, dev) != hipSuccess) { grid = -1; return; }
        if (hipFuncSetAttribute((const void*)fwd_kernel, hipFuncAttributeMaxDynamicSharedMemorySize, LDS_BYTES) != hipSuccess) { fprintf(stderr, "kernel_launch: hipFuncSetAttribute failed\n"); grid = -1; return; }
        if (hipOccupancyMaxActiveBlocksPerMultiprocessor(&per_cu, (const void*)fwd_kernel, NWAVES * 64, LDS_BYTES) != hipSuccess || per_cu < 1) { fprintf(stderr, "kernel_launch: occupancy query reports %d blocks per CU\n", per_cu); }
        (void)hipGetLastError();
        grid = cus;
    }
    if (grid < 0) return;
    (void)hipMemsetAsync((char*)d_ws + WS_CTL, 0, CTL_ZERO_BYTES, stream);
    Args a{};
    for (int i = 0; i < 23; ++i) a.in[i] = (const float*)d_in[i];
    a.out = (float*)d_out; a.ws = (unsigned char*)d_ws; a.pad = 0;
#if MK_ONE_LAUNCH
    a.ph_lo = 0; a.ph_hi = N_PHASES; a.use_bar = 1;
    hipLaunchKernelGGL(fwd_kernel, dim3(grid), dim3(NWAVES * 64), LDS_BYTES, stream, a);
#else
    for (int ph = 0; ph < N_PHASES; ++ph) {
        if (ph >= 1 && ph < N_PHASES - 1) { const int layer = (ph - 1) / SLOTS, slot = (ph - 1) % SLOTS; if ((layer & 1) == 0 && (slot == 5 || slot == 6)) continue; }
        a.ph_lo = ph; a.ph_hi = ph + 1; a.use_bar = 0;
        hipLaunchKernelGGL(fwd_kernel, dim3(grid), dim3(NWAVES * 64), LDS_BYTES, stream, a);
    }
#endif
    const hipError_t le = hipPeekAtLastError();
    if (le != hipSuccess) fprintf(stderr, "kernel_launch: launch failed: %s\n", hipGetErrorName(le));
}
```

```cpp
#include <hip/hip_runtime.h>
#include <cstdio>
#include <cstdint>
#include <cmath>
namespace pg8 {
#define PG8_LAS __attribute__((address_space(3)))
typedef unsigned short bf16_t;
typedef short bf16x8 __attribute__((ext_vector_type(8)));
typedef float f32x4 __attribute__((ext_vector_type(4)));
typedef unsigned u32x4 __attribute__((ext_vector_type(4)));
constexpr int BM = 256, BK = 64, HALF = 128, HTB = HALF * BK * 2  , STAGE_BYTES = 8 * HTB, NXCD = 8, WGM = 4;

__host__ __device__ __forceinline__ int lds_byte(int r, int c) { const int st = (r >> 4) * 2 + (c >> 5), rr = r & 15, cc = c & 31, ob = rr * 64 + cc * 2; return st * 1024 + (ob ^ (((ob >> 9) & 1) << 5)); }
__host__ __device__ __forceinline__ void stage_rc(int b, int& R, int& C) { const int st = b / 1024, sb = b % 1024, swz = sb ^ (((sb >> 9) & 1) << 5); R = (st >> 1) * 16 + swz / 64; C = (st & 1) * 32 + (swz % 64) / 2; }
__host__ __device__ __forceinline__ int perm32(int rho) { const int n = rho >> 4, i = rho & 15; return 8 * (i >> 2) + 4 * n + (i & 3); }

struct Unit { int pm, pn, koff, aux; };
struct Gemm { const bf16_t* A; const bf16_t* Bt; int M, N, K, ld; };

struct StaticOrder {
    int nM, nN, nwg, G, c;
    __host__ __device__ void init(int M, int N, int G_, int c_) { nM = M / BM; nN = N / BM; nwg = nM * nN; G = G_; c = c_; }
    __host__ __device__ bool next(int i, Unit& u) const {
        const long L = (long)i * G + c; if (L >= nwg) return false;
        int wgid = (int)L; { const int q = nwg / NXCD, r = nwg % NXCD, xcd = wgid % NXCD, off = wgid / NXCD; wgid = (xcd < r ? xcd * (q + 1) : r * (q + 1) + (xcd - r) * q) + off; }
        const int nig = WGM * nN, gid = wgid / nig, fm = gid * WGM, gsz = (nM - fm) < WGM ? (nM - fm) : WGM;
        u.pm = fm + ((wgid % nig) % gsz); u.pn = (wgid % nig) / gsz; u.koff = 0; u.aux = 0; return true;
    }
    __device__ __forceinline__ void a_ready(const Unit&) const {}
    __device__ __forceinline__ void done(const Unit&) const {}
};

struct SliceOrder {
    int nN, nS, ks, G, c;
    __host__ __device__ void init(int N, int nslices, int kslice, int G_, int c_) { nN = N / BM; nS = nslices; ks = kslice; G = G_; c = c_; }
    __host__ __device__ bool next(int i, Unit& u) const { const int L = i * G + c; if (L >= nN * nS) return false; u.pm = 0; u.pn = L % nN; u.aux = L / nN; u.koff = u.aux * ks; return true; }
    __device__ __forceinline__ void a_ready(const Unit&) const {}
    __device__ __forceinline__ void done(const Unit&) const {}
};

__device__ __forceinline__ unsigned cvt_pk_bf16(float lo, float hi) { unsigned r; asm volatile("v_cvt_pk_bf16_f32 %0, %1, %2" : "=v"(r) : "v"(lo), "v"(hi)); return r; }

struct EpiBf16 {
    static constexpr bool PERM = true, AFTER_DRAIN = false;
    bf16_t* O; int ldc;
    __device__ __forceinline__ void operator()(const f32x4 (&acc)[2][2][4][2], const Unit& u, int wr, int wc, int fr, int fq) const {
        const int row0 = u.pm * BM + wr * 64 + fr, col0 = u.pn * BM + wc * 32 + 8 * fq;
#pragma unroll
        for (int ai = 0; ai < 2; ++ai)
#pragma unroll
            for (int m = 0; m < 4; ++m) { bf16_t* rowp = O + (size_t)(row0 + ai * HALF + m * 16) * ldc + col0;
#pragma unroll
                for (int bj = 0; bj < 2; ++bj) { const f32x4 v0 = acc[ai][bj][m][0], v1 = acc[ai][bj][m][1];
                    u32x4 w; w.x = cvt_pk_bf16(v0[0], v0[1]); w.y = cvt_pk_bf16(v0[2], v0[3]); w.z = cvt_pk_bf16(v1[0], v1[1]); w.w = cvt_pk_bf16(v1[2], v1[3]);
                    *(u32x4*)(rowp + bj * HALF) = w; } }
    }
};
struct EpiQKV {
    static constexpr bool PERM = true, AFTER_DRAIN = false;
    bf16_t* O; int ldc; const float* rope;
    __device__ __forceinline__ void operator()(const f32x4 (&acc)[2][2][4][2], const Unit& u, int wr, int wc, int fr, int fq) const {
        const int row0 = u.pm * BM + wr * 64 + fr, col0 = u.pn * BM + wc * 32 + 8 * fq;
        const bool do_rope = (u.pm >= 1) && (u.pn < 8 || (u.pn >= 12 && u.pn <= 16));
        const int jg = 4 * wc + fq, axis = jg >> 3, f0 = 4 * (jg & 7);
#pragma unroll
        for (int ai = 0; ai < 2; ++ai)
#pragma unroll
            for (int m = 0; m < 4; ++m) { const int row = row0 + ai * HALF + m * 16; bf16_t* rowp = O + (size_t)row * ldc + col0;
                f32x4 cs = (f32x4){1.f, 1.f, 1.f, 1.f}, sn = (f32x4){0.f, 0.f, 0.f, 0.f};
                if (do_rope) { const int t = row - 256; const int pos = axis ? (t & 63) : (t >> 6); cs = *(const f32x4*)(rope + pos * 32 + f0); sn = *(const f32x4*)(rope + 8192 + pos * 32 + f0); }
#pragma unroll
                for (int bj = 0; bj < 2; ++bj) { const f32x4 x1 = acc[ai][bj][m][0], x2 = acc[ai][bj][m][1];
                    const f32x4 v0 = x1 * cs - x2 * sn, v1 = x2 * cs + x1 * sn;
                    u32x4 w; w.x = cvt_pk_bf16(v0[0], v0[1]); w.y = cvt_pk_bf16(v0[2], v0[3]); w.z = cvt_pk_bf16(v1[0], v1[1]); w.w = cvt_pk_bf16(v1[2], v1[3]);
                    *(u32x4*)(rowp + bj * HALF) = w; } }
    }
};
struct EpiDnIn {
    static constexpr bool PERM = true, AFTER_DRAIN = false;
    bf16_t* RAW; bf16_t* Z; float* GATES;
    __device__ __forceinline__ void operator()(const f32x4 (&acc)[2][2][4][2], const Unit& u, int wr, int wc, int fr, int fq) const {
        const int row0 = u.pm * BM + wr * 64 + fr;
        if (u.pn < 48) {
            bf16_t* base; int ldc, colt;
            if (u.pn < 32) { base = RAW; ldc = 8192; colt = u.pn * BM; } else { base = Z; ldc = 4096; colt = (u.pn - 32) * BM; }
            const int col0 = colt + wc * 32 + 8 * fq;
#pragma unroll
            for (int ai = 0; ai < 2; ++ai)
#pragma unroll
                for (int m = 0; m < 4; ++m) { bf16_t* rowp = base + (size_t)(row0 + ai * HALF + m * 16) * ldc + col0;
#pragma unroll
                    for (int bj = 0; bj < 2; ++bj) { const f32x4 v0 = acc[ai][bj][m][0], v1 = acc[ai][bj][m][1];
                        u32x4 w; w.x = cvt_pk_bf16(v0[0], v0[1]); w.y = cvt_pk_bf16(v0[2], v0[3]); w.z = cvt_pk_bf16(v1[0], v1[1]); w.w = cvt_pk_bf16(v1[2], v1[3]);
                        *(u32x4*)(rowp + bj * HALF) = w; } }
        } else {
            const int col0 = wc * 32 + 8 * fq;
#pragma unroll
            for (int ai = 0; ai < 2; ++ai)
#pragma unroll
                for (int m = 0; m < 4; ++m) { float* rowp = GATES + (size_t)(row0 + ai * HALF + m * 16) * 128 + col0;
                    *(f32x4*)(rowp) = acc[ai][0][m][0]; *(f32x4*)(rowp + 4) = acc[ai][0][m][1]; }
        }
    }
};
struct EpiResid {
    static constexpr bool PERM = false, AFTER_DRAIN = false;
    float* X; int ldc; const float* gate_lat; const float* gate_ctx;
    __device__ __forceinline__ void operator()(const f32x4 (&acc)[2][2][4][2], const Unit& u, int wr, int wc, int fr, int fq) const {
        const int row0 = u.pm * BM + wr * 64 + fr, col0 = u.pn * BM + wc * 32 + 4 * fq;
        const float* gate = (u.pm == 0) ? gate_ctx : gate_lat;
        f32x4 gv[2][2];
#pragma unroll
        for (int bj = 0; bj < 2; ++bj)
#pragma unroll
            for (int n = 0; n < 2; ++n) gv[bj][n] = *(const f32x4*)(gate + col0 + bj * HALF + n * 16);
        f32x4 xa[4], xb[4];
#define ER_ROW(g) (X + (size_t)(row0 + ((g) >> 2) * HALF + ((g) & 3) * 16) * ldc + col0)
#define ER_LD(xv, g) do { const float* rp_ = ER_ROW(g); _Pragma("unroll") for (int q = 0; q < 4; ++q) xv[q] = *(const f32x4*)(rp_ + (q >> 1) * HALF + (q & 1) * 16); } while (0)
#define ER_ST(xv, g) do { float* rp_ = ER_ROW(g); _Pragma("unroll") for (int q = 0; q < 4; ++q) *(f32x4*)(rp_ + (q >> 1) * HALF + (q & 1) * 16) = xv[q] + gv[q >> 1][q & 1] * acc[(g) >> 2][q >> 1][(g) & 3][q & 1]; } while (0)
        ER_LD(xa, 0);
#pragma unroll
        for (int g = 0; g < 8; g += 2) {
            ER_LD(xb, g + 1); asm volatile("" ::: "memory");
            ER_ST(xa, g); asm volatile("" ::: "memory");
            if (g + 2 < 8) ER_LD(xa, g + 2);
            asm volatile("" ::: "memory");
            ER_ST(xb, g + 1); asm volatile("" ::: "memory");
        }
#undef ER_ROW
#undef ER_LD
#undef ER_ST
    }
};

struct EpiPart {
    static constexpr bool PERM = false, AFTER_DRAIN = false;
    float* P; int ldc;
    __device__ __forceinline__ void operator()(const f32x4 (&acc)[2][2][4][2], const Unit& u, int wr, int wc, int fr, int fq) const {
        const int row0 = wr * 64 + fr, col0 = u.pn * BM + wc * 32 + 4 * fq; float* base = P + (size_t)u.aux * BM * ldc;
#pragma unroll
        for (int ai = 0; ai < 2; ++ai)
#pragma unroll
            for (int m = 0; m < 4; ++m) { float* rowp = base + (size_t)(row0 + ai * HALF + m * 16) * ldc + col0;
#pragma unroll
                for (int bj = 0; bj < 2; ++bj)
#pragma unroll
                    for (int n = 0; n < 2; ++n) *(f32x4*)(rowp + bj * HALF + n * 16) = acc[ai][bj][m][n]; }
    }
};
template <class Epi, class Sched, bool ALIGN_EPI = false, bool SP2 = false>
__device__ __forceinline__ void gemm_phase(PG8_LAS unsigned char* lds, const Gemm g, const Sched& S, const Epi& E, int tid_in) {
    const int tid = tid_in, wid = __builtin_amdgcn_readfirstlane(tid >> 6), lane = tid & 63, wr = wid >> 2, wc = wid & 3, fr = lane & 15, fq = lane >> 4;
    const int K = g.ld, nt = g.K / BK;
    unsigned voffA[2], voffB[2];
#pragma unroll
    for (int i = 0; i < 2; ++i) { int R, C; stage_rc(tid * 16 + i * 8192, R, C); const int Rb = Epi::PERM ? ((R & ~31) + perm32(R & 31)) : R;
        voffA[i] = (unsigned)(R * K + C) * 2u; voffB[i] = (unsigned)(Rb * K + C) * 2u; }
    const size_t kstep = (size_t)(BK * 2);
    const size_t hstep = (size_t)HALF * K * 2;
    const size_t tstep = 2 * hstep;
    const unsigned ldsw = (unsigned)wid * 1024u;
    const int aoff = lds_byte(wr * 64 + fr, fq * 8), boff = lds_byte(wc * 32 + fr, fq * 8);
#define PG8_SA(b, h) (((b) * 2 + (h)) * HTB)
#define PG8_SB(b, h) ((4 + (b) * 2 + (h)) * HTB)
#define PG8_STAGE(bufoff, gbase, voff) do { _Pragma("unroll") for (int _i = 0; _i < 2; ++_i) \
        __builtin_amdgcn_global_load_lds((const unsigned*)((const char*)(gbase) + (voff)[_i]), (PG8_LAS unsigned*)(lds + (bufoff) + ldsw + _i * 8192), 16, 0, 0); } while (0)
#define PG8_LDA(dst, b, h) do { _Pragma("unroll") for (int m = 0; m < 4; ++m) _Pragma("unroll") for (int k = 0; k < 2; ++k) dst[m][k] = *(const PG8_LAS bf16x8*)(lds + PG8_SA(b, h) + aoff + m * 2048 + k * 1024); } while (0)
#define PG8_LDB(dst, b, h) do { _Pragma("unroll") for (int n = 0; n < 2; ++n) _Pragma("unroll") for (int k = 0; k < 2; ++k) dst[n][k] = *(const PG8_LAS bf16x8*)(lds + PG8_SB(b, h) + boff + n * 2048 + k * 1024); } while (0)
#define PG8_MMA(ai, bj, At, Bt) do { __builtin_amdgcn_s_setprio(1); _Pragma("unroll") for (int m = 0; m < 4; ++m) _Pragma("unroll") for (int n = 0; n < 2; ++n) _Pragma("unroll") for (int k = 0; k < 2; ++k) \
        acc[ai][bj][m][n] = __builtin_amdgcn_mfma_f32_16x16x32_bf16(Bt[n][k], At[m][k], acc[ai][bj][m][n], 0, 0, 0); __builtin_amdgcn_s_setprio(0); } while (0)
#define PG8_WAIT_V(n) asm volatile("s_waitcnt vmcnt(" #n ")" ::: "memory")
#define PG8_WAIT_L(n) asm volatile("s_waitcnt lgkmcnt(" #n ")" ::: "memory")
#define PG8_BAR __builtin_amdgcn_s_barrier()
#define PG8_SCHED __builtin_amdgcn_sched_barrier(0)
    Unit cur, nxt; int ui = 0;
    if (!S.next(0, cur)) return;
    f32x4 acc[2][2][4][2];
#pragma unroll
    for (int a = 0; a < 2; ++a)
#pragma unroll
        for (int b = 0; b < 2; ++b)
#pragma unroll
            for (int m = 0; m < 4; ++m)
#pragma unroll
                for (int n = 0; n < 2; ++n) acc[a][b][m][n] = (f32x4){0.f, 0.f, 0.f, 0.f};
    bf16x8 At[4][2], B0[2][2], B1[2][2];
    const char* cA = (const char*)g.A + (size_t)cur.pm * tstep + (size_t)cur.koff * 2; const char* cB = (const char*)g.Bt + (size_t)cur.pn * tstep + (size_t)cur.koff * 2;
    S.a_ready(cur);
    if constexpr (SP2) {
        PG8_STAGE(PG8_SB(0, 0), cB, voffB); PG8_STAGE(PG8_SB(0, 1), cB + hstep, voffB); PG8_STAGE(PG8_SA(0, 0), cA, voffA); PG8_STAGE(PG8_SA(0, 1), cA + hstep, voffA);
        if (wr == 1) PG8_BAR;
        PG8_WAIT_V(2); PG8_BAR;
        PG8_STAGE(PG8_SB(1, 0), cB + kstep, voffB); PG8_STAGE(PG8_SA(1, 0), cA + kstep, voffA); PG8_STAGE(PG8_SB(1, 1), cB + hstep + kstep, voffB);
        PG8_WAIT_V(6); PG8_BAR;
    } else {
        PG8_STAGE(PG8_SB(0, 0), cB, voffB); PG8_STAGE(PG8_SA(0, 0), cA, voffA); PG8_STAGE(PG8_SB(0, 1), cB + hstep, voffB); PG8_STAGE(PG8_SA(0, 1), cA + hstep, voffA);
        if (wr == 1) PG8_BAR;
        PG8_WAIT_V(4); PG8_BAR;
        PG8_STAGE(PG8_SB(1, 0), cB + kstep, voffB); PG8_STAGE(PG8_SA(1, 0), cA + kstep, voffA); PG8_STAGE(PG8_SB(1, 1), cB + hstep + kstep, voffB);
        PG8_WAIT_V(6); PG8_BAR;
    }
    for (;;) {
        const bool has_next = S.next(ui + 1, nxt);
        const char* nA = has_next ? (const char*)g.A + (size_t)nxt.pm * tstep + (size_t)nxt.koff * 2 : cA; const char* nB = has_next ? (const char*)g.Bt + (size_t)nxt.pn * tstep + (size_t)nxt.koff * 2 : cB;
        for (int t = 0; t < nt; t += 2) {
            const bool last = (t == nt - 2);
            const char* a1 = cA + (size_t)(t + 1) * kstep;
            const char* a2 = last ? nA : cA + (size_t)(t + 2) * kstep; const char* b2 = last ? nB : cB + (size_t)(t + 2) * kstep;
            const char* a3 = a2 + kstep; const char* b3 = b2 + kstep;
            if (last && has_next) S.a_ready(nxt);
            if constexpr (SP2) {
            PG8_LDB(B0, 0, 0); PG8_LDB(B1, 0, 1); PG8_SCHED; PG8_LDA(At, 0, 0); PG8_STAGE(PG8_SA(1, 1), a1 + hstep, voffA);
            PG8_WAIT_V(8); PG8_WAIT_L(0); PG8_BAR; PG8_MMA(0, 0, At, B0); PG8_MMA(0, 1, At, B1); PG8_BAR; PG8_SCHED;
            PG8_LDA(At, 0, 1); PG8_STAGE(PG8_SB(0, 0), b2, voffB); PG8_STAGE(PG8_SB(0, 1), b2 + hstep, voffB); PG8_STAGE(PG8_SA(0, 0), a2, voffA);
            PG8_WAIT_V(8); PG8_WAIT_L(0); PG8_BAR; PG8_MMA(1, 0, At, B0); PG8_MMA(1, 1, At, B1); PG8_BAR; PG8_SCHED;
            PG8_LDB(B0, 1, 0); PG8_LDB(B1, 1, 1); PG8_SCHED; PG8_LDA(At, 1, 0); PG8_STAGE(PG8_SA(0, 1), a2 + hstep, voffA);
            PG8_WAIT_V(8); PG8_WAIT_L(0); PG8_BAR; PG8_MMA(0, 0, At, B0); PG8_MMA(0, 1, At, B1); PG8_BAR; PG8_SCHED;
            PG8_LDA(At, 1, 1); PG8_STAGE(PG8_SB(1, 0), b3, voffB); PG8_STAGE(PG8_SB(1, 1), b3 + hstep, voffB); PG8_STAGE(PG8_SA(1, 0), a3, voffA);
            PG8_WAIT_V(8); PG8_WAIT_L(0); PG8_BAR; PG8_MMA(1, 0, At, B0); PG8_MMA(1, 1, At, B1); PG8_BAR; PG8_SCHED;
            } else {
            PG8_LDB(B0, 0, 0); PG8_SCHED; PG8_LDA(At, 0, 0); PG8_STAGE(PG8_SA(1, 1), a1 + hstep, voffA);
            PG8_WAIT_L(8); PG8_BAR; PG8_WAIT_L(0); PG8_MMA(0, 0, At, B0); PG8_BAR; PG8_SCHED;
            PG8_LDB(B1, 0, 1); PG8_STAGE(PG8_SB(0, 0), b2, voffB);
            PG8_BAR; PG8_WAIT_L(0); PG8_MMA(0, 1, At, B1); PG8_BAR;
            PG8_LDA(At, 0, 1); PG8_STAGE(PG8_SA(0, 0), a2, voffA);
            PG8_BAR; PG8_WAIT_L(0); PG8_MMA(1, 0, At, B0); PG8_BAR; PG8_SCHED;
            PG8_STAGE(PG8_SB(0, 1), b2 + hstep, voffB);
            PG8_WAIT_V(6); PG8_BAR; PG8_MMA(1, 1, At, B1); PG8_BAR;
            PG8_LDB(B0, 1, 0); PG8_SCHED; PG8_LDA(At, 1, 0); PG8_STAGE(PG8_SA(0, 1), a2 + hstep, voffA);
            PG8_WAIT_L(8); PG8_BAR; PG8_WAIT_L(0); PG8_MMA(0, 0, At, B0); PG8_BAR; PG8_SCHED;
            PG8_LDB(B1, 1, 1); PG8_STAGE(PG8_SB(1, 0), b3, voffB);
            PG8_BAR; PG8_WAIT_L(0); PG8_MMA(0, 1, At, B1); PG8_BAR;
            PG8_LDA(At, 1, 1); PG8_STAGE(PG8_SA(1, 0), a3, voffA);
            PG8_BAR; PG8_WAIT_L(0); PG8_MMA(1, 0, At, B0); PG8_BAR; PG8_SCHED;
            PG8_STAGE(PG8_SB(1, 1), b3 + hstep, voffB);
            PG8_WAIT_V(6); PG8_BAR; PG8_MMA(1, 1, At, B1); PG8_BAR;
            }
        }
        if constexpr (ALIGN_EPI) { if (wr == 0) PG8_BAR; }
        if constexpr (!Epi::AFTER_DRAIN) { E(acc, cur, wr, wc, fr, fq); S.done(cur); }
        if (!has_next) break;
#pragma unroll
        for (int a = 0; a < 2; ++a)
#pragma unroll
            for (int b = 0; b < 2; ++b)
#pragma unroll
                for (int m = 0; m < 4; ++m)
#pragma unroll
                    for (int n = 0; n < 2; ++n) acc[a][b][m][n] = (f32x4){0.f, 0.f, 0.f, 0.f};
        cur = nxt; cA = nA; cB = nB; ++ui;
        if constexpr (ALIGN_EPI) { if (wr == 1) PG8_BAR; }
    }
    PG8_WAIT_V(0);
    if constexpr (!ALIGN_EPI) { if (wr == 0) PG8_BAR; }
    PG8_BAR;
    if constexpr (Epi::AFTER_DRAIN) { E.fused(acc, cur, wr, wc, fr, fq, lds, wid, lane); S.done(cur); }
#undef PG8_SA
#undef PG8_SB
#undef PG8_STAGE
#undef PG8_LDA
#undef PG8_LDB
#undef PG8_MMA
#undef PG8_WAIT_V
#undef PG8_WAIT_L
#undef PG8_BAR
#undef PG8_SCHED
}
}

namespace att {
using bf16x8 = __attribute__((ext_vector_type(8))) short;
using s16x4  = __attribute__((ext_vector_type(4))) short;
using f32x16 = __attribute__((ext_vector_type(16))) float;
using u32x4  = __attribute__((ext_vector_type(4))) unsigned;
typedef unsigned short bf16;
constexpr int   D = 128, NW = 8, QBLK = 32, KVBLK = 64;
constexpr float SCALE = 0.088388347648318440f;
constexpr float THR = 8.f;
constexpr size_t SHM_V = KVBLK * D * 2, SHM_K = KVBLK * D * 2, SHM_ATTN = 2 * SHM_V + 2 * SHM_K + NW * 64 * 4;
#define KSWZ(row, colB) ((row) * 256 + ((colB) ^ (((row) & 7) << 4)))
#define SBAR() __builtin_amdgcn_sched_barrier(0)
__device__ __forceinline__ int crow(int r, int hi) { return (r & 3) + 8 * (r >> 2) + 4 * hi; }
__device__ __forceinline__ unsigned cvtpk(float lo, float hi) { unsigned r; asm volatile("v_cvt_pk_bf16_f32 %0, %1, %2" : "=v"(r) : "v"(lo), "v"(hi)); return r; }

__device__ __forceinline__ void partialSM(f32x16& p0, f32x16& p1, float& m_reg, float& mn, float& alpha) {
  constexpr float C = SCALE * 1.4426950408889634f;
  float pmax = p0[0]; for (int r = 1; r < 16; ++r) pmax = fmaxf(pmax, p0[r]); for (int r = 0; r < 16; ++r) pmax = fmaxf(pmax, p1[r]);
  { auto rr = __builtin_amdgcn_permlane32_swap(__float_as_uint(pmax), __float_as_uint(pmax), false, false);
    pmax = fmaxf(__uint_as_float(rr[0]), __uint_as_float(rr[1])); }
  if (__builtin_expect(__all(pmax - m_reg <= THR / SCALE), 1)) { mn = m_reg; alpha = 1.f; }
  else { mn = fmaxf(m_reg, pmax); alpha = __builtin_amdgcn_exp2f((m_reg - mn) * C); m_reg = mn; }
  float mnC = -mn * C;
  for (int r = 0; r < 16; ++r) p0[r] = fmaf(p0[r], C, mnC); for (int r = 0; r < 16; ++r) p1[r] = fmaf(p1[r], C, mnC);
  for (int r = 0; r < 16; ++r) p0[r] = __builtin_amdgcn_exp2f(p0[r]);
}
__device__ __forceinline__ void finishSM(f32x16& p0, f32x16& p1, float alpha, float& l_reg, bf16x8& pa0, bf16x8& pa1, bf16x8& pa2, bf16x8& pa3) {
  for (int r = 0; r < 16; ++r) p1[r] = __builtin_amdgcn_exp2f(p1[r]);
  float ps = 0; for (int r = 0; r < 16; ++r) ps += p0[r]; for (int r = 0; r < 16; ++r) ps += p1[r];
  { auto rr = __builtin_amdgcn_permlane32_swap(__float_as_uint(ps), __float_as_uint(ps), false, false);
    ps = __uint_as_float(rr[0]) + __uint_as_float(rr[1]); }
  l_reg = l_reg * alpha + ps;
#define PK4(P, BASE, OUT) do { unsigned a0 = cvtpk(P[BASE + 0], P[BASE + 1]), a1 = cvtpk(P[BASE + 2], P[BASE + 3]);   \
    unsigned b0 = cvtpk(P[BASE + 4], P[BASE + 5]), b1 = cvtpk(P[BASE + 6], P[BASE + 7]);                              \
    auto r0 = __builtin_amdgcn_permlane32_swap(a0, b0, false, false); auto r1 = __builtin_amdgcn_permlane32_swap(a1, b1, false, false); \
    u32x4 w = {r0[0], r1[0], r0[1], r1[1]}; OUT = *reinterpret_cast<bf16x8*>(&w); } while (0)
  PK4(p0, 0, pa0); PK4(p0, 8, pa1); PK4(p1, 0, pa2); PK4(p1, 8, pa3);
#undef PK4
}
__device__ __forceinline__ void qkt(f32x16& p0, f32x16& p1, const bf16* Ks, const bf16x8* qr, int r32, int hi) {
  p0 = f32x16{}; p1 = f32x16{};
  for (int d0 = 0; d0 < 8; ++d0) { int cb = (d0 * 16 + hi * 8) * 2;
    bf16x8 b0 = *reinterpret_cast<const bf16x8*>((const char*)Ks + KSWZ(r32, cb));
    bf16x8 b1 = *reinterpret_cast<const bf16x8*>((const char*)Ks + KSWZ(32 + r32, cb));
    p0 = __builtin_amdgcn_mfma_f32_32x32x16_bf16(b0, qr[d0], p0, 0, 0, 0);
    p1 = __builtin_amdgcn_mfma_f32_32x32x16_bf16(b1, qr[d0], p1, 0, 0, 0); }
}
__device__ __forceinline__ void wmask(f32x16& p0, f32x16& p1, int dq  , int hi) {
#pragma unroll
  for (int r = 0; r < 16; ++r) { const int d0 = dq - crow(r, hi), d1 = d0 - 32;
    p0[r] = (d0 <= 128 && d0 >= -128) ? p0[r] : -1e30f; p1[r] = (d1 <= 128 && d1 >= -128) ? p1[r] : -1e30f; }
}
__device__ __forceinline__ int v_st(int k, int c) { const int kk = (k & ~0xC) | ((k & 4) << 1) | ((k & 8) >> 1); return ((kk >> 3) * 4 + (c >> 5)) * 512 + ((kk & 7) * 32 + (c & 31)) * 2; }
__device__ __forceinline__ int v_rd_base(int lane) { return ((lane & 3) << 3) | (((lane >> 2) & 3) << 6) | (((lane >> 4) & 1) << 5) | (((lane >> 5) & 1) << 8); }
constexpr int v_rd_off(int d0, int ks, int half) { return d0 * 512 + ks * 4096 + half * 2048; }
template <int OFF> __device__ __forceinline__ s16x4 tr_read(int vb) {
  s16x4 r; asm volatile("ds_read_b64_tr_b16 %0, %1 offset:%2" : "=&v"(r) : "v"(vb), "i"(OFF) : "memory"); return r;
}
template <int D0> __device__ __forceinline__ void pv_one(f32x16& od, int vb, bf16x8 pa0, bf16x8 pa1, bf16x8 pa2, bf16x8 pa3) {
  const s16x4 l0 = tr_read<v_rd_off(D0, 0, 0)>(vb), h0 = tr_read<v_rd_off(D0, 0, 1)>(vb), l1 = tr_read<v_rd_off(D0, 1, 0)>(vb), h1 = tr_read<v_rd_off(D0, 1, 1)>(vb);
  const s16x4 l2 = tr_read<v_rd_off(D0, 2, 0)>(vb), h2 = tr_read<v_rd_off(D0, 2, 1)>(vb), l3 = tr_read<v_rd_off(D0, 3, 0)>(vb), h3 = tr_read<v_rd_off(D0, 3, 1)>(vb);
  asm volatile("s_waitcnt lgkmcnt(0)" ::: "memory"); SBAR();
#define PK(L, H) (bf16x8){L[0], L[1], L[2], L[3], H[0], H[1], H[2], H[3]}
  od = __builtin_amdgcn_mfma_f32_32x32x16_bf16(pa0, PK(l0, h0), od, 0, 0, 0);
  od = __builtin_amdgcn_mfma_f32_32x32x16_bf16(pa1, PK(l1, h1), od, 0, 0, 0);
  od = __builtin_amdgcn_mfma_f32_32x32x16_bf16(pa2, PK(l2, h2), od, 0, 0, 0);
  od = __builtin_amdgcn_mfma_f32_32x32x16_bf16(pa3, PK(l3, h3), od, 0, 0, 0);
#undef PK
}
__device__ __forceinline__ void pv_d0(f32x16* o, int vb, bf16x8 pa0, bf16x8 pa1, bf16x8 pa2, bf16x8 pa3) {
  pv_one<0>(o[0], vb, pa0, pa1, pa2, pa3); pv_one<1>(o[1], vb, pa0, pa1, pa2, pa3); pv_one<2>(o[2], vb, pa0, pa1, pa2, pa3); pv_one<3>(o[3], vb, pa0, pa1, pa2, pa3);
}
template <bool MASKED, int LDQ, int LDK, int LDO, int SD>
__device__ __forceinline__ void attn_body(const bf16* __restrict__ Qb, const bf16* __restrict__ Kh, const bf16* __restrict__ Vh,
                                          float* __restrict__ Ob, int NT, int wb, int q0, float sinkl2, char* lds, int tid_in) {
  int tid_l = tid_in; asm volatile("" : "+v"(tid_l)); const int tid = tid_l, wid = tid >> 6, lane = tid & 63, r32 = lane & 31, hi = lane >> 5;
  bf16* V_lds = (bf16*)lds; bf16* K_lds = (bf16*)(lds + 2 * SHM_V);
  float* ws = (float*)(lds + 2 * SHM_V + 2 * SHM_K) + wid * 64; float* li_l = ws; float* al_l = ws + 32;
  float m_reg = -1e30f, l_reg = 0; f32x16 o[4] = {}; bf16x8 qr[8];
  const bf16* Qw = Qb + (long)(wid * QBLK + r32) * LDQ + hi * 8;
#pragma unroll
  for (int d0 = 0; d0 < 8; ++d0) qr[d0] = *reinterpret_cast<const bf16x8*>(Qw + d0 * 16);
  const int sr = tid >> 4, sc = (tid & 15) * 8, vst0 = v_st(sr, sc), vst1 = v_st(32 + sr, sc);
  const int vb0 = (int)(uintptr_t)V_lds + v_rd_base(lane);
  const int qpos = q0 + wid * QBLK + r32;
  struct { bf16x8 vs0, vs1, ks0, ks1; } sr_[SD];
#define KB(j) (MASKED ? ((j) < 4 ? (j) * KVBLK : wb + ((j) - 4) * KVBLK) : (j) * KVBLK)
#define SLOAD(i, k0) do { sr_[i].vs0 = *reinterpret_cast<const bf16x8*>(&Vh[(long)((k0) + sr) * LDK + sc]); sr_[i].vs1 = *reinterpret_cast<const bf16x8*>(&Vh[(long)((k0) + 32 + sr) * LDK + sc]); \
    sr_[i].ks0 = *reinterpret_cast<const bf16x8*>(&Kh[(long)((k0) + sr) * LDK + sc]); sr_[i].ks1 = *reinterpret_cast<const bf16x8*>(&Kh[(long)((k0) + 32 + sr) * LDK + sc]); } while (0)
#define SWRITE(b, i) do { *(bf16x8*)((char*)V_lds + (b) * SHM_V + vst0) = sr_[i].vs0;          \
    *(bf16x8*)((char*)V_lds + (b) * SHM_V + vst1) = sr_[i].vs1; int kc = sc * 2;               \
    *(bf16x8*)((char*)K_lds + (b) * SHM_K + KSWZ(sr, kc)) = sr_[i].ks0;                       \
    *(bf16x8*)((char*)K_lds + (b) * SHM_K + KSWZ(32 + sr, kc)) = sr_[i].ks1; } while (0)
#define SWAIT() do { if (SD == 2) asm volatile("s_waitcnt vmcnt(4)" ::: "memory"); else asm volatile("s_waitcnt vmcnt(0)" ::: "memory"); } while (0)
#define RESC(a) do { if (__any((a) < 1.f)) { if (hi == 0) al_l[r32] = (a); asm volatile("s_waitcnt lgkmcnt(0)" ::: "memory"); \
    for (int d = 0; d < 4; ++d) for (int r = 0; r < 16; ++r) o[d][r] *= al_l[crow(r, hi)]; } } while (0)
#define MASK(P0, P1, j) do { if (MASKED) { if ((j) >= 4) wmask(P0, P1, qpos - (KB(j) - 256), hi); } } while (0)
  f32x16 pA0, pA1, pB0, pB1; float mnA, mnB, alA, alB; bf16x8 pa0, pa1, pa2, pa3;
  constexpr int SE = 0, SO = SD - 1;
  SLOAD(SE, KB(0)); asm volatile("s_waitcnt vmcnt(0)" ::: "memory"); SWRITE(0, SE); __syncthreads();
  qkt(pA0, pA1, K_lds, qr, r32, hi); partialSM(pA0, pA1, m_reg, mnA, alA);
  SLOAD(SO, KB(1)); if (SD == 2) { if (2 < NT) SLOAD(SE, KB(2)); }
  SWAIT(); SWRITE(1, SO); __syncthreads();
  for (int j = 1; j + 1 < NT; j += 2) {
    SBAR(); qkt(pB0, pB1, (bf16*)((char*)K_lds + SHM_K), qr, r32, hi); MASK(pB0, pB1, j);
    finishSM(pA0, pA1, alA, l_reg, pa0, pa1, pa2, pa3); SBAR();
    SLOAD(SO, KB(j + SD)); SBAR();
    pv_d0(o, vb0, pa0, pa1, pa2, pa3); partialSM(pB0, pB1, m_reg, mnB, alB);
    __syncthreads(); SWAIT(); SWRITE(0, SE);
    RESC(alB); __syncthreads();
    SBAR(); qkt(pA0, pA1, K_lds, qr, r32, hi); MASK(pA0, pA1, j + 1);
    finishSM(pB0, pB1, alB, l_reg, pa0, pa1, pa2, pa3); SBAR();
    if (SD == 1 || j + 3 < NT) SLOAD(SE, KB(j + 1 + SD)); SBAR();
    pv_d0(o, vb0 + (int)SHM_V, pa0, pa1, pa2, pa3); partialSM(pA0, pA1, m_reg, mnA, alA);
    __syncthreads(); SWAIT(); SWRITE(1, SO);
    RESC(alA); __syncthreads();
  }
  SBAR(); qkt(pB0, pB1, (bf16*)((char*)K_lds + SHM_K), qr, r32, hi); MASK(pB0, pB1, NT - 1);
  finishSM(pA0, pA1, alA, l_reg, pa0, pa1, pa2, pa3); SBAR();
  pv_d0(o, vb0, pa0, pa1, pa2, pa3); partialSM(pB0, pB1, m_reg, mnB, alB);
  __syncthreads(); RESC(alB);
  finishSM(pB0, pB1, alB, l_reg, pa0, pa1, pa2, pa3); SBAR();
  pv_d0(o, vb0 + (int)SHM_V, pa0, pa1, pa2, pa3);
  l_reg += __builtin_amdgcn_exp2f(sinkl2 - m_reg * (SCALE * 1.4426950408889634f));
  if (hi == 0) li_l[r32] = l_reg; asm volatile("s_waitcnt lgkmcnt(0)" ::: "memory");
  float rli[16];
#pragma unroll
  for (int r = 0; r < 16; ++r) rli[r] = __builtin_amdgcn_rcpf(li_l[crow(r, hi)]);
  float* Ow = Ob + (long)(wid * QBLK) * LDO;
#pragma unroll
  for (int r = 0; r < 16; ++r) { int orow = crow(r, hi);
    for (int d0 = 0; d0 < 4; ++d0) Ow[(long)orow * LDO + d0 * 32 + r32] = o[d0][r] * rli[r]; }
  __syncthreads();
#undef KB
#undef SLOAD
#undef SWRITE
#undef SWAIT
#undef RESC
#undef MASK
}

__device__ __forceinline__ void qkt_batched(f32x16& p0, f32x16& p1, const bf16* Ks, const bf16x8* qr, int r32, int hi) {
  p0 = f32x16{}; p1 = f32x16{};
  bf16x8 k0[4], k1[4], k2[4];
#define KRD(kb, D) do { _Pragma("unroll") for (int d = 0; d < 2; ++d) { const int cb = (((D) + d) * 16 + hi * 8) * 2; \
    kb[2 * d] = *reinterpret_cast<const bf16x8*>((const char*)Ks + KSWZ(r32, cb)); kb[2 * d + 1] = *reinterpret_cast<const bf16x8*>((const char*)Ks + KSWZ(32 + r32, cb)); } } while (0)
#define KMM(kb, D) do { _Pragma("unroll") for (int d = 0; d < 2; ++d) { p0 = __builtin_amdgcn_mfma_f32_32x32x16_bf16(kb[2 * d], qr[(D) + d], p0, 0, 0, 0); p1 = __builtin_amdgcn_mfma_f32_32x32x16_bf16(kb[2 * d + 1], qr[(D) + d], p1, 0, 0, 0); } } while (0)
  KRD(k0, 0); SBAR(); KRD(k1, 2); SBAR();
  asm volatile("s_waitcnt lgkmcnt(4)" ::: "memory"); SBAR();
  KRD(k2, 4); SBAR(); KMM(k0, 0); SBAR();
  asm volatile("s_waitcnt lgkmcnt(4)" ::: "memory"); SBAR();
  KRD(k0, 6); SBAR(); KMM(k1, 2); SBAR();
  asm volatile("s_waitcnt lgkmcnt(4)" ::: "memory"); SBAR();
  KMM(k2, 4); SBAR();
  asm volatile("s_waitcnt lgkmcnt(0)" ::: "memory"); SBAR();
  KMM(k0, 6); SBAR();
#undef KRD
#undef KMM
}
__device__ __forceinline__ void pv_batched(f32x16* o, int vb, bf16x8 pa0, bf16x8 pa1, bf16x8 pa2, bf16x8 pa3) {
  s16x4 L0[4], H0[4], L1[4], H1[4];
#define TRD(Lb, Hb, D0) Lb[0] = tr_read<v_rd_off(D0, 0, 0)>(vb); Hb[0] = tr_read<v_rd_off(D0, 0, 1)>(vb); Lb[1] = tr_read<v_rd_off(D0, 1, 0)>(vb); Hb[1] = tr_read<v_rd_off(D0, 1, 1)>(vb); \
    Lb[2] = tr_read<v_rd_off(D0, 2, 0)>(vb); Hb[2] = tr_read<v_rd_off(D0, 2, 1)>(vb); Lb[3] = tr_read<v_rd_off(D0, 3, 0)>(vb); Hb[3] = tr_read<v_rd_off(D0, 3, 1)>(vb);
#define PK(Lv, Hv) (bf16x8){Lv[0], Lv[1], Lv[2], Lv[3], Hv[0], Hv[1], Hv[2], Hv[3]}
#define MM(D0, Lb, Hb) o[D0] = __builtin_amdgcn_mfma_f32_32x32x16_bf16(pa0, PK(Lb[0], Hb[0]), o[D0], 0, 0, 0); o[D0] = __builtin_amdgcn_mfma_f32_32x32x16_bf16(pa1, PK(Lb[1], Hb[1]), o[D0], 0, 0, 0); \
    o[D0] = __builtin_amdgcn_mfma_f32_32x32x16_bf16(pa2, PK(Lb[2], Hb[2]), o[D0], 0, 0, 0); o[D0] = __builtin_amdgcn_mfma_f32_32x32x16_bf16(pa3, PK(Lb[3], Hb[3]), o[D0], 0, 0, 0);
  TRD(L0, H0, 0) SBAR(); TRD(L1, H1, 1) SBAR();
  asm volatile("s_waitcnt lgkmcnt(8)" ::: "memory"); SBAR();
  MM(0, L0, H0) SBAR();
  TRD(L0, H0, 2) SBAR();
  asm volatile("s_waitcnt lgkmcnt(8)" ::: "memory"); SBAR();
  MM(1, L1, H1) SBAR();
  TRD(L1, H1, 3) SBAR();
  asm volatile("s_waitcnt lgkmcnt(8)" ::: "memory"); SBAR();
  MM(2, L0, H0) SBAR();
  asm volatile("s_waitcnt lgkmcnt(0)" ::: "memory"); SBAR();
  MM(3, L1, H1) SBAR();
#undef TRD
#undef PK
#undef MM
}
constexpr int AP_V = 0, AP_K = 65536, AP_P = 98304, AP_AL = 131072, AP_M = 132096, AP_FL = 132608, AP_LX = 132672, AP_END = 133696;
template <int LDQ, int LDK, int LDO>
__device__ __forceinline__ void attn_pair_body(const bf16* __restrict__ Qb, const bf16* __restrict__ Kh, const bf16* __restrict__ Vh, float* __restrict__ Ob, int NT, char* lds, int tid_in) {
  int tid_l = tid_in; asm volatile("" : "+v"(tid_l)); const int tid = tid_l, wid = __builtin_amdgcn_readfirstlane(tid >> 6), lane = tid & 63, r32 = lane & 31, hi = lane >> 5;
  const int rg = wid & 3, vhw = wid >> 2;
  char* V_lds = lds + AP_V; char* K_lds = lds + AP_K;
  char* Pp = lds + AP_P + rg * 8192;
  float* ALp = (float*)(lds + AP_AL) + rg * 64; float* Mp = (float*)(lds + AP_M) + rg * 32; unsigned* FLp = (unsigned*)(lds + AP_FL) + rg * 2; float* LXp = (float*)(lds + AP_LX) + rg * 64;
  float m_reg = -1e30f, l_reg = 0.f; f32x16 o[4] = {}; bf16x8 qr[8];
  const bf16* Qw = Qb + (long)(rg * QBLK + r32) * LDQ + hi * 8;
#pragma unroll
  for (int d0 = 0; d0 < 8; ++d0) qr[d0] = *reinterpret_cast<const bf16x8*>(Qw + d0 * 16);
  const int sr = tid >> 4, sc = (tid & 15) * 8, vst0 = v_st(sr, sc), vst1 = v_st(32 + sr, sc);
  const int vb0 = (int)(uintptr_t)(V_lds + vhw * 16384) + v_rd_base(lane);
  bf16x8 ks0, ks1, vs00, vs01, vs10, vs11;
#define KLOAD(k0) do { ks0 = *reinterpret_cast<const bf16x8*>(&Kh[(long)((k0) + sr) * LDK + sc]); ks1 = *reinterpret_cast<const bf16x8*>(&Kh[(long)((k0) + 32 + sr) * LDK + sc]); } while (0)
#define VLOAD(k0) do { vs00 = *reinterpret_cast<const bf16x8*>(&Vh[(long)((k0) + sr) * LDK + sc]); vs01 = *reinterpret_cast<const bf16x8*>(&Vh[(long)((k0) + 32 + sr) * LDK + sc]); \
    vs10 = *reinterpret_cast<const bf16x8*>(&Vh[(long)((k0) + sr) * LDK + 128 + sc]); vs11 = *reinterpret_cast<const bf16x8*>(&Vh[(long)((k0) + 32 + sr) * LDK + 128 + sc]); } while (0)
#define KWRITE(b) do { const int kc = sc * 2; *(bf16x8*)(K_lds + (b) * 16384 + KSWZ(sr, kc)) = ks0; *(bf16x8*)(K_lds + (b) * 16384 + KSWZ(32 + sr, kc)) = ks1; } while (0)
#define VWRITE(b) do { *(bf16x8*)(V_lds + (b) * 32768 + vst0) = vs00; *(bf16x8*)(V_lds + (b) * 32768 + vst1) = vs01; \
    *(bf16x8*)(V_lds + (b) * 32768 + 16384 + vst0) = vs10; *(bf16x8*)(V_lds + (b) * 32768 + 16384 + vst1) = vs11; } while (0)
  KLOAD(0); asm volatile("s_waitcnt vmcnt(0)" ::: "memory"); KWRITE(0);
  if (NT > 1) { KLOAD(KVBLK); asm volatile("s_waitcnt vmcnt(0)" ::: "memory"); KWRITE(1); }
  if (NT > 2) KLOAD(2 * KVBLK);
  VLOAD(0);
  __syncthreads();
  f32x16 p0 = f32x16{}, p1 = f32x16{};
  if (vhw == 0) { qkt_batched(p0, p1, (const bf16*)K_lds, qr, r32, hi); }
  __syncthreads();
#pragma unroll 1
  for (int j = 0; j <= NT; ++j) {
    const int b = j & 1, pb = b ^ 1;
    const bool prod = (j < NT) && (b == vhw);
    if (prod) __builtin_amdgcn_s_setprio(2); else __builtin_amdgcn_s_setprio(0);
    const bool flp = (j >= 1) && (__builtin_amdgcn_readfirstlane((int)FLp[pb]) != 0);
    const float alp_v = ALp[pb * 32 + r32], m_v = Mp[r32];
    const bf16x8 a0 = *reinterpret_cast<const bf16x8*>(Pp + pb * 4096 + 0 * 1024 + lane * 16), a1 = *reinterpret_cast<const bf16x8*>(Pp + pb * 4096 + 1 * 1024 + lane * 16);
    const bf16x8 a2 = *reinterpret_cast<const bf16x8*>(Pp + pb * 4096 + 2 * 1024 + lane * 16), a3 = *reinterpret_cast<const bf16x8*>(Pp + pb * 4096 + 3 * 1024 + lane * 16);
    SBAR();
    KWRITE(b);
    VWRITE(b);
    { const int tk = j + 3 < NT ? j + 3 : NT - 1, tv = j + 1 < NT ? j + 1 : NT - 1; KLOAD(tk * KVBLK); VLOAD(tv * KVBLK); }
    SBAR();
    if (prod) {
      if (flp) l_reg *= alp_v;
      if (j >= 1) m_reg = m_v;
      float mn, al; bf16x8 pa0, pa1, pa2, pa3;
      partialSM(p0, p1, m_reg, mn, al);
      finishSM(p0, p1, al, l_reg, pa0, pa1, pa2, pa3);
      *reinterpret_cast<bf16x8*>(Pp + b * 4096 + 0 * 1024 + lane * 16) = pa0; *reinterpret_cast<bf16x8*>(Pp + b * 4096 + 1 * 1024 + lane * 16) = pa1;
      *reinterpret_cast<bf16x8*>(Pp + b * 4096 + 2 * 1024 + lane * 16) = pa2; *reinterpret_cast<bf16x8*>(Pp + b * 4096 + 3 * 1024 + lane * 16) = pa3;
      if (hi == 0) { ALp[b * 32 + r32] = al; Mp[r32] = m_reg; }
      const unsigned fl = __any(al < 1.f) ? 1u : 0u;
      if (lane == 0) FLp[b] = fl;
      SBAR();
    }
    if (j >= 1) {
      if (flp) {
#pragma unroll
        for (int d = 0; d < 4; ++d)
#pragma unroll
          for (int r = 0; r < 16; ++r) o[d][r] *= ALp[pb * 32 + crow(r, hi)];
      }
      pv_batched(o, vb0 + pb * 32768, a0, a1, a2, a3);
    }
    if (!prod && j + 1 < NT) { SBAR(); qkt_batched(p0, p1, (const bf16*)(K_lds + pb * 16384), qr, r32, hi); SBAR(); }
    __syncthreads();
  }
  __builtin_amdgcn_s_setprio(0);
  if (hi == 0) LXp[vhw * 32 + r32] = l_reg;
  __syncthreads();
  float rli[16];
#pragma unroll
  for (int r = 0; r < 16; ++r) rli[r] = __builtin_amdgcn_rcpf(LXp[crow(r, hi)] + LXp[32 + crow(r, hi)]);
  float* Ow = Ob + (long)(rg * QBLK) * LDO + vhw * 128;
#pragma unroll
  for (int r = 0; r < 16; ++r) { int orow = crow(r, hi);
    for (int d0 = 0; d0 < 4; ++d0) Ow[(long)orow * LDO + d0 * 32 + r32] = o[d0][r] * rli[r]; }
  __syncthreads();
#undef KLOAD
#undef VLOAD
#undef KWRITE
#undef VWRITE
}
#undef KSWZ
#undef SBAR
}

constexpr int DM = 2048, SEQ = 16384, CTXN = 256, MR = SEQ + CTXN  , DEPTH = 4;
constexpr int ATTN_IN = 4608, DN_INP = 12544  , DN_IN = 12416, FFH = 5632, FFU = 2 * FFH;
constexpr float EPS = 1e-6f;
constexpr int NWAVES = 8;
constexpr size_t MiB = 1u << 20;
constexpr size_t WS_CTL = 0, CTL_ZERO_BYTES = 64 * 1024;
constexpr size_t WS_MOD = 1 * MiB;
constexpr size_t WS_ROPE = WS_MOD + 512 * 1024;
constexpr size_t WS_LAM = WS_ROPE + 128 * 1024;
constexpr size_t WS_WIN = 2 * MiB, WS_WOUT = 51 * MiB, WS_WUP = 67 * MiB, WS_WDN = 111 * MiB;
constexpr size_t WS_X = 134 * MiB;
constexpr size_t WS_Z = 264 * MiB;
constexpr size_t WS_R1 = 394 * MiB;
constexpr size_t WS_H = WS_R1;
constexpr size_t WS_HM_ATT = WS_R1 + 65 * MiB;
constexpr size_t WS_QKRM = WS_R1;
constexpr size_t WS_VT = WS_R1 + 130 * MiB;
constexpr size_t WS_KT = WS_R1 + 260 * MiB;
constexpr size_t WS_QF = WS_R1 + 325 * MiB;
constexpr size_t WS_O = WS_R1;
constexpr size_t WS_BG = WS_R1 + 390 * MiB;
constexpr size_t WS_GATES = WS_BG + 9 * MiB;
constexpr size_t WS_R2 = WS_GATES + 9 * MiB;
constexpr size_t WS_ITEMS = WS_R2;
constexpr size_t WS_RAW = WS_R2;
constexpr size_t WS_HM_DN = WS_R2;
constexpr size_t WS_QKV = WS_R2;
constexpr size_t WS_OA = WS_R2 + 147 * MiB;
constexpr size_t WS_OB = WS_OA + 130 * MiB;
constexpr size_t WS_U = WS_R2;
constexpr size_t WS_A2 = WS_R2 + 358 * MiB;
constexpr size_t WS_P = WS_R2 + 538 * MiB;
constexpr size_t WS_END = WS_R2 + 667 * MiB;
static_assert(WS_END <= 1536 * MiB, "workspace map exceeds 1536 MiB");
static_assert(WS_R2 == 802 * MiB && WS_A2 + (size_t)MR * FFH * 2 <= WS_END && WS_OB + (size_t)MR * 1024 * 4 <= WS_END && WS_ITEMS + (size_t)260 * 64 * 41984 <= WS_END, "ws map");
constexpr int CW_BAR = 1024;

constexpr int RING_BYTES = 131072;
constexpr int LDS_BYTES = 163840;
constexpr int MISC_OFF = LDS_BYTES - 256, ARGT_OFF = LDS_BYTES - 512;

#define GAS __attribute__((address_space(1)))
#define LAS __attribute__((address_space(3)))
typedef unsigned short bf16;
typedef unsigned v4u __attribute__((ext_vector_type(4)));
typedef unsigned v2u __attribute__((ext_vector_type(2)));
typedef float f32x4 __attribute__((ext_vector_type(4)));
__device__ __forceinline__ const float* lds_arg(__attribute__((address_space(3))) unsigned char* lds, int i) { const unsigned long long v = *(const __attribute__((address_space(3))) unsigned long long*)(lds + ARGT_OFF + i * 8);
    return (const float*)(((unsigned long long)(unsigned)__builtin_amdgcn_readfirstlane((int)(v >> 32)) << 32) | (unsigned long long)(unsigned)__builtin_amdgcn_readfirstlane((int)(unsigned)v)); }
#define AIN(i) lds_arg(F.lds, (i))
#define LDS_WAIT() asm volatile("s_waitcnt lgkmcnt(0)" ::: "memory")
#define VM_WAIT() asm volatile("s_waitcnt vmcnt(0)" ::: "memory")
typedef float f32x2_cv __attribute__((ext_vector_type(2))); typedef __bf16 bf16x2_cv __attribute__((ext_vector_type(2)));
__device__ __forceinline__ unsigned pk2(float lo, float hi) { const f32x2_cv v = {lo, hi}; const bf16x2_cv b = __builtin_convertvector(v, bf16x2_cv); return __builtin_bit_cast(unsigned, b); }
__device__ __forceinline__ float bflo(unsigned u) { return __uint_as_float(u << 16); }
__device__ __forceinline__ float bfhi(unsigned u) { return __uint_as_float(u & 0xffff0000u); }
__device__ __forceinline__ float bf2f(bf16 b) { return __uint_as_float(((unsigned)b) << 16); }
__device__ __forceinline__ float siluf(float x) { return x / (1.f + __expf(-x)); }
__device__ __forceinline__ float shx(float v, int mask, int lane) { return __int_as_float(__builtin_amdgcn_ds_bpermute((lane ^ mask) << 2, __float_as_int(v))); }
__device__ __forceinline__ float shl_from(float v, int src_lane) { return __int_as_float(__builtin_amdgcn_ds_bpermute(src_lane << 2, __float_as_int(v))); }
__device__ __forceinline__ float wave_sum(float v, int lane) {
#pragma unroll
    for (int o = 1; o < 64; o <<= 1) v += shx(v, o, lane);
    return v;
}
#define XB_TMO      128
#define XB_XCNT(j)  (256  + 64 * (j))
#define XB_XSUB(j)  (1280 + 64 * (j))
#define XB_XGEN(j)  (2304 + 64 * (j))
#define XB_TOP      3328
#define XB_TOPGEN   3392
#define XCD_BAR_WORDS 3456
#define XB_SPIN_CAP (1u << 20)

__device__ __forceinline__ unsigned xb_ld(unsigned* p)              { return __hip_atomic_load(p, __ATOMIC_RELAXED, __HIP_MEMORY_SCOPE_AGENT); }
__device__ __forceinline__ unsigned xb_add(unsigned* p, unsigned v) { return __hip_atomic_fetch_add(p, v, __ATOMIC_RELAXED, __HIP_MEMORY_SCOPE_AGENT); }
__device__ __forceinline__ unsigned xb_xcc_id() { return (unsigned)__builtin_amdgcn_s_getreg((3 << 11) | 20) & 0xFu; }
#define XB_SPIN(cond, bar) do { unsigned _sp = 0; while (cond) { __builtin_amdgcn_s_sleep(4); \
    if ((++_sp & 255u) == 0u) { if (xb_ld(&(bar)[XB_TMO])) break; if (_sp > XB_SPIN_CAP) { atomicAdd(&(bar)[XB_TMO], 1u); break; } } } } while (0)

struct XcdBarrier {
    unsigned* bar; unsigned x;
    volatile LAS unsigned* st;
};

__device__ __forceinline__ XcdBarrier xcd_barrier_post(unsigned* bar, volatile LAS unsigned* st) {
    XcdBarrier b; b.bar = bar; b.x = xb_xcc_id(); b.st = st;
    if (threadIdx.x == 0) (void)xb_add(&bar[XB_XCNT(b.x)], 1u);
    return b;
}
__device__ __forceinline__ void xcd_barrier_complete(unsigned* bar, unsigned x, unsigned& nloc, unsigned& nx) {
    const unsigned G = gridDim.x * gridDim.y * gridDim.z;
    unsigned sum, cnt, mine, sp = 0u;
    for (;;) {
        sum = 0u; cnt = 0u; mine = 0u;
#pragma unroll
        for (unsigned j = 0; j < 16; ++j) { const unsigned c = xb_ld(&bar[XB_XCNT(j)]); sum += c; cnt += (c > 0u) ? 1u : 0u; mine = (j == x) ? c : mine; }
        if (sum == G) break;
        __builtin_amdgcn_s_sleep(4);
        if ((++sp & 255u) == 0u) { if (xb_ld(&bar[XB_TMO])) break; if (sp > XB_SPIN_CAP) { atomicAdd(&bar[XB_TMO], 1u); break; } }
    }
    nloc = mine > 0u ? mine : 1u; nx = cnt > 0u ? cnt : 1u;
}

__device__ __forceinline__ void xcd_barrier(const XcdBarrier& b) {
    asm volatile("s_waitcnt vmcnt(0)" ::: "memory");
    __syncthreads();
    if (threadIdx.x == 0) {
        unsigned* bar = b.bar;
        __builtin_amdgcn_s_waitcnt(0);
        unsigned nloc = b.st[0], nx = b.st[1];
        if (nloc == 0u) { xcd_barrier_complete(bar, b.x, nloc, nx); b.st[0] = nloc; b.st[1] = nx; }
        const unsigned old = xb_add(&bar[XB_XSUB(b.x)], 1u);
        const unsigned gen = old / nloc;
        if (old + 1u == (gen + 1u) * nloc) {
            __builtin_amdgcn_fence(__ATOMIC_RELEASE, "agent");
            asm volatile("s_waitcnt vmcnt(0)" ::: "memory");
            const unsigned og = xb_add(&bar[XB_TOP], 1u);
            const unsigned tg = og / nx;
            if (og + 1u == (tg + 1u) * nx) xb_add(&bar[XB_TOPGEN], 1u);
            else XB_SPIN(xb_ld(&bar[XB_TOPGEN]) == tg, bar);
            __builtin_amdgcn_fence(__ATOMIC_ACQUIRE, "agent");
            xb_add(&bar[XB_XGEN(b.x)], 1u);
            asm volatile("s_waitcnt vmcnt(0)" ::: "memory");
        } else {
            XB_SPIN(xb_ld(&bar[XB_XGEN(b.x)]) == gen, bar);
            __builtin_amdgcn_fence(__ATOMIC_ACQUIRE, "agent");
            asm volatile("s_waitcnt vmcnt(0)" ::: "memory");
        }
    }
    __syncthreads();
}

struct Frame {
    LAS unsigned char* lds;
    int tid, lane, wave, G, gw, NGW;
};
struct Args { const float* in[23]; float* out; unsigned char* ws; int ph_lo, ph_hi, use_bar, pad; };
enum { I_X = 0, I_C, I_CTX, I_CCTX, I_WMOD, I_BMOD, I_N1G, I_N2G, I_AWIN, I_DLAM, I_SUBLN, I_SINK, I_AWOUT, I_DWIN, I_DCONV, I_DALOG, I_DDT, I_DNG, I_DWOUT, I_FUP, I_FCONV, I_FDN, I_FING };

__device__ __forceinline__ void p0_prologue(const Frame& F, unsigned char* ws) {
    const size_t gtid = (size_t)blockIdx.x * 512 + F.tid, NT = (size_t)F.G * 512;
    {
        f32x4* X4 = (f32x4*)(ws + WS_X); const f32x4* c4 = (const f32x4*)AIN(I_CTX); const f32x4* x4 = (const f32x4*)AIN(I_X);
        const size_t n4c = (size_t)CTXN * DM / 4, n4x = (size_t)SEQ * DM / 4;
        for (size_t i = gtid; i < n4c; i += NT) X4[i] = c4[i];
        for (size_t i = gtid; i < n4x; i += NT) X4[n4c + i] = x4[i];
    }
    {
        float* rope = (float*)(ws + WS_ROPE);
        for (size_t i = gtid; i < 8192; i += NT) { const int pos = (int)(i >> 5), f = (int)(i & 31); const float inv = powf(10000.f, -(float)f / 32.f); const float ang = (float)pos * inv;
            rope[i] = cosf(ang); rope[8192 + i] = sinf(ang); }
    }
    if (blockIdx.x == 0 && F.tid < 2) {
        const float* lf = AIN(I_DLAM) + F.tid * 512; float s01 = 0.f, s23 = 0.f;
        for (int d = 0; d < 128; ++d) { s01 += lf[d] * lf[128 + d]; s23 += lf[256 + d] * lf[384 + d]; }
        const float lam_init = F.tid == 0 ? 0.2f : 0.4707130183435842f;
        ((float*)(ws + WS_LAM))[F.tid] = expf(s01) - expf(s23) + lam_init;
    }
    {
        LAS float* sl = (LAS float*)F.lds; LAS float* sc = sl + 2048; LAS float* red = sc + 2048;
        for (int k = F.tid; k < 2048; k += 512) { sl[k] = siluf(AIN(I_C)[k]); sc[k] = siluf(AIN(I_CCTX)[k]); }
        __syncthreads();
        float* MOD = (float*)(ws + WS_MOD);
        for (int it = blockIdx.x; it < 192; it += F.G) {
            const int layer = it / 48, nb = it % 48, n = nb * 256 + F.lane * 4;
            const float* W = AIN(I_WMOD) + (size_t)layer * 2048 * 12288 + n;
            f32x4 al = (f32x4){0.f, 0.f, 0.f, 0.f}, ac = al;
            const int k0 = F.wave * 256;
#pragma unroll 8
            for (int k = k0; k < k0 + 256; ++k) { const f32x4 w = *(const f32x4*)(W + (size_t)k * 12288); al += sl[k] * w; ac += sc[k] * w; }
            *(LAS f32x4*)(red + (F.wave * 2 + 0) * 256 + F.lane * 4) = al; *(LAS f32x4*)(red + (F.wave * 2 + 1) * 256 + F.lane * 4) = ac;
            __syncthreads();
            { const int which = F.tid >> 8, col = F.tid & 255; float s = AIN(I_BMOD)[layer * 12288 + nb * 256 + col];
#pragma unroll
              for (int w = 0; w < 8; ++w) s += red[(w * 2 + which) * 256 + col];
              MOD[(size_t)(layer * 2 + which) * 12288 + nb * 256 + col] = s; }
            __syncthreads();
        }
    }
}

__device__ __forceinline__ void transpose_item(const float* W, int K, int N, bf16* WT, LAS float* scr, int item, int lane, bool ropemode) {
    const int nblk = N / 32, kb = item / nblk, nb = item % nblk, k0 = 64 * kb, n0 = 32 * nb;
    int src = n0 + (lane & 31);
    if (ropemode) { const int blk = src >> 8; if (blk < 8 || (blk >= 12 && blk <= 16)) { const int p = src & 127, j = p >> 3, i = p & 7; src = (src & ~127) + 64 * (j >> 3) + 4 * (j & 7) + (i & 3) + 32 * (i >> 2); } }
    float wv[32];
#pragma unroll
    for (int i = 0; i < 32; ++i) { const int kk = 2 * i + (lane >> 5); wv[i] = W[(size_t)(k0 + kk) * N + src]; }
#pragma unroll
    for (int i = 0; i < 32; ++i) { const int kk = 2 * i + (lane >> 5); scr[kk * 33 + (lane & 31)] = wv[i]; }
    LDS_WAIT(); asm volatile("" ::: "memory");
    const int c = lane & 7;
#pragma unroll
    for (int j = 0; j < 4; ++j) { const int n = (lane >> 3) + 8 * j; const LAS float* s = scr + (8 * c) * 33 + n;
        v4u o; o.x = pk2(s[0 * 33], s[1 * 33]); o.y = pk2(s[2 * 33], s[3 * 33]); o.z = pk2(s[4 * 33], s[5 * 33]); o.w = pk2(s[6 * 33], s[7 * 33]);
        *(v4u*)(WT + (size_t)(n0 + n) * K + k0 + 8 * c) = o; }
    LDS_WAIT(); asm volatile("" ::: "memory");
}
__device__ __forceinline__ void convert_layer_weights(const Frame& F, unsigned char* ws, int layer) {
    const int li = layer >> 1;
    LAS float* scr = (LAS float*)(F.lds + 32768 + F.wave * 8448);
    bf16* WIN = (bf16*)(ws + WS_WIN); bf16* WOUT = (bf16*)(ws + WS_WOUT); bf16* WUP = (bf16*)(ws + WS_WUP); bf16* WDN = (bf16*)(ws + WS_WDN);
    const float* up = AIN(I_FUP) + (size_t)layer * DM * FFU; const float* dn = AIN(I_FDN) + (size_t)layer * FFH * DM;
    const int I_up = (DM / 64) * (FFU / 32), I_dn = (FFH / 64) * (DM / 32);
    if ((layer & 1) == 0) {
        const float* win = AIN(I_AWIN) + (size_t)li * DM * ATTN_IN; const float* wout = AIN(I_AWOUT) + (size_t)li * DM * DM;
        const int I_in = (DM / 64) * (ATTN_IN / 32), I_out = (DM / 64) * (DM / 32), NI = I_in + I_out + I_up + I_dn;
        for (int it = F.gw; it < NI; it += F.NGW) { int r = it;
            if (r < I_in) { transpose_item(win, DM, ATTN_IN, WIN, scr, r, F.lane, true); continue; } r -= I_in;
            if (r < I_out) { transpose_item(wout, DM, DM, WOUT, scr, r, F.lane, false); continue; } r -= I_out;
            if (r < I_up) { transpose_item(up, DM, FFU, WUP, scr, r, F.lane, false); continue; } r -= I_up;
            transpose_item(dn, FFH, DM, WDN, scr, r, F.lane, false); }
    } else {
        const float* win = AIN(I_DWIN) + (size_t)li * DM * DN_IN; const float* wout = AIN(I_DWOUT) + (size_t)li * 4096 * DM;
        const int I_in = (DM / 64) * (DN_IN / 32), I_out = (4096 / 64) * (DM / 32), NI = I_in + I_out + I_up + I_dn;
        for (int it = F.gw; it < NI; it += F.NGW) { int r = it;
            if (r < I_in) { transpose_item(win, DM, DN_IN, WIN, scr, r, F.lane, false); continue; } r -= I_in;
            if (r < I_out) { transpose_item(wout, 4096, DM, WOUT, scr, r, F.lane, false); continue; } r -= I_out;
            if (r < I_up) { transpose_item(up, DM, FFU, WUP, scr, r, F.lane, false); continue; } r -= I_up;
            transpose_item(dn, FFH, DM, WDN, scr, r, F.lane, false); }
        v4u* z = (v4u*)(WIN + (size_t)DN_IN * DM); const size_t nz = (size_t)(DN_INP - DN_IN) * DM * 2 / 16;
        for (size_t i = (size_t)blockIdx.x * 512 + F.tid; i < nz; i += (size_t)F.G * 512) z[i] = (v4u){0u, 0u, 0u, 0u};
    }
}

__device__ __forceinline__ void norm_phase(const Frame& F, float* X, bf16* H, const float* gain, const float* mod_lat, const float* mod_ctx, int sh_chunk, const float* P, int pend_ks, const float* pend_gate) {
    LAS float* V = (LAS float*)F.lds;
    for (int k = F.tid; k < 2048; k += 512) { const float g = gain[k];
        V[k] = g * (1.f + mod_lat[(sh_chunk + 1) * 2048 + k]); V[2048 + k] = mod_lat[sh_chunk * 2048 + k];
        V[4096 + k] = g * (1.f + mod_ctx[(sh_chunk + 1) * 2048 + k]); V[6144 + k] = mod_ctx[sh_chunk * 2048 + k]; }
    __syncthreads();
    for (int r = F.gw; r < MR; r += F.NGW) {
        const f32x4* xr = (const f32x4*)(X + (size_t)r * DM) + F.lane; const LAS float* A = V + (r < CTXN ? 4096 : 0); const LAS float* B = A + 2048;
        f32x4 v[8]; float ss = 0.f;
#pragma unroll
        for (int j = 0; j < 8; ++j) v[j] = xr[64 * j];
        if (pend_ks > 0 && r < CTXN) {
            f32x4 acc[8];
#pragma unroll
            for (int j = 0; j < 8; ++j) acc[j] = (f32x4){0.f, 0.f, 0.f, 0.f};
            for (int ks = 0; ks < pend_ks; ++ks) { const f32x4* pr = (const f32x4*)(P + ((size_t)ks * CTXN + r) * DM) + F.lane;
#pragma unroll
                for (int j = 0; j < 8; ++j) acc[j] += pr[64 * j]; }
            f32x4* xw = (f32x4*)(X + (size_t)r * DM) + F.lane;
#pragma unroll
            for (int j = 0; j < 8; ++j) { v[j] += *((const f32x4*)pend_gate + F.lane + 64 * j) * acc[j]; xw[64 * j] = v[j]; }
        }
#pragma unroll
        for (int j = 0; j < 8; ++j) ss += (v[j].x * v[j].x + v[j].y * v[j].y) + (v[j].z * v[j].z + v[j].w * v[j].w);
        const float rstd = rsqrtf(wave_sum(ss, F.lane) * (1.f / DM) + EPS);
        v2u* o8 = (v2u*)(H + (size_t)r * DM) + F.lane;
#pragma unroll
        for (int j = 0; j < 8; ++j) { const int col = (F.lane + 64 * j) * 4; const f32x4 av = *(const LAS f32x4*)(A + col), bv = *(const LAS f32x4*)(B + col);
            const f32x4 y = v[j] * rstd * av + bv; v2u w; w.x = pk2(y.x, y.y); w.y = pk2(y.z, y.w); o8[64 * j] = w; }
    }
    __syncthreads();
}

__device__ __forceinline__ void merge_phase(const Frame& F, const float* OA, const float* OB, bf16* HM, const float* subln, float lam, float lam_init) {
    const f32x4 g = *((const f32x4*)subln + F.lane);
    for (int r = F.gw; r < MR; r += F.NGW) {
        const f32x4* oa = (const f32x4*)(OA + (size_t)r * 2048) + F.lane; v2u* hm = (v2u*)(HM + (size_t)r * 2048) + F.lane;
#pragma unroll
        for (int h = 0; h < 4; ++h) { const f32x4 o0 = oa[h * 128], o1 = oa[h * 128 + 64]; const f32x4 d = o0 - lam * o1;
            const float ss = wave_sum((d.x * d.x + d.y * d.y) + (d.z * d.z + d.w * d.w), F.lane);
            const float rs = rsqrtf(ss * (1.f / 256.f) + EPS) * (1.f - lam_init); const f32x4 y = d * rs * g;
            v2u w; w.x = pk2(y.x, y.y); w.y = pk2(y.z, y.w); hm[h * 64] = w; }
        const f32x4* ob = (const f32x4*)(OB + (size_t)r * 1024) + F.lane;
#pragma unroll
        for (int j = 0; j < 4; ++j) { const f32x4 y = ob[64 * j]; v2u w; w.x = pk2(y.x, y.y); w.y = pk2(y.z, y.w); hm[256 + 64 * j] = w; }
    }
}

struct Row8 { float v[8]; };
__device__ __forceinline__ Row8 unpack8(v4u p) { Row8 r; r.v[0] = bflo(p.x); r.v[1] = bfhi(p.x); r.v[2] = bflo(p.y); r.v[3] = bfhi(p.y); r.v[4] = bflo(p.z); r.v[5] = bfhi(p.z); r.v[6] = bflo(p.w); r.v[7] = bfhi(p.w); return r; }

__device__ __forceinline__ void convgate_phase(const Frame& F, const bf16* U, bf16* A2, const float* cw, int run0) {
    constexpr int NSTRIP = FFH / 512, NRUN = MR / 32;
    for (int it = F.gw + run0 * NSTRIP; it < NSTRIP * NRUN; it += F.NGW) {
        const int strip = it % NSTRIP, run = it / NSTRIP, c0 = strip * 512 + F.lane * 8, r0 = run * 32;
        const int seg_lo = r0 < CTXN ? 0 : CTXN, seg_hi = r0 < CTXN ? CTXN : MR;
        float wg[3][8], wu[3][8];
#pragma unroll
        for (int t = 0; t < 3; ++t)
#pragma unroll
            for (int i = 0; i < 8; ++i) { wg[t][i] = cw[t * FFU + c0 + i]; wu[t][i] = cw[t * FFU + FFH + c0 + i]; }
        const v4u zero = (v4u){0u, 0u, 0u, 0u};
#pragma unroll 1
        for (int g8 = 0; g8 < 4; ++g8) {
            v4u gr[10], ur[10];
#pragma unroll
            for (int k = 0; k < 10; ++k) { const int rk = r0 + g8 * 8 - 1 + k; const bool ok = rk >= seg_lo && rk < seg_hi;
                gr[k] = ok ? *(const v4u*)(U + (size_t)rk * FFU + c0) : zero; ur[k] = ok ? *(const v4u*)(U + (size_t)rk * FFU + FFH + c0) : zero; }
#pragma unroll
            for (int rr = 0; rr < 8; ++rr) {
                const int r = r0 + g8 * 8 + rr;
                const Row8 a0 = unpack8(gr[rr]), a1 = unpack8(gr[rr + 1]), a2 = unpack8(gr[rr + 2]), b0 = unpack8(ur[rr]), b1 = unpack8(ur[rr + 1]), b2 = unpack8(ur[rr + 2]);
                float o[8];
#pragma unroll
                for (int i = 0; i < 8; ++i) { const float g = wg[0][i] * a0.v[i] + wg[1][i] * a1.v[i] + wg[2][i] * a2.v[i]; const float u = wu[0][i] * b0.v[i] + wu[1][i] * b1.v[i] + wu[2][i] * b2.v[i]; o[i] = siluf(g) * u; }
                v4u w; w.x = pk2(o[0], o[1]); w.y = pk2(o[2], o[3]); w.z = pk2(o[4], o[5]); w.w = pk2(o[6], o[7]);
                *(v4u*)(A2 + (size_t)r * FFH + c0) = w;
            }
        }
    }
}

__device__ __forceinline__ void dnconv_phase(const Frame& F, const bf16* RAW, bf16* QKVN, const float* cw, const float* GATES, float* BG, const float* a_log, const float* dt_bias) {
    constexpr int NSTRIP = 8192 / 512, NRUN = MR / 32;
    for (int it = F.gw; it < NSTRIP * NRUN; it += F.NGW) {
        const int strip = it % NSTRIP, run = it / NSTRIP, c0 = strip * 512 + F.lane * 8, r0 = run * 32;
        const int seg_lo = r0 < CTXN ? 0 : CTXN, seg_hi = r0 < CTXN ? CTXN : MR;
        float w[3][8];
#pragma unroll
        for (int t = 0; t < 3; ++t)
#pragma unroll
            for (int i = 0; i < 8; ++i) w[t][i] = cw[t * 8192 + c0 + i];
        const v4u zero = (v4u){0u, 0u, 0u, 0u};
        v4u xp = zero, xc;
        if (r0 - 1 >= seg_lo) xp = *(const v4u*)(RAW + (size_t)(r0 - 1) * 8192 + c0);
        xc = *(const v4u*)(RAW + (size_t)r0 * 8192 + c0);
        const float qscale = strip < 4 ? 0.088388347648318440f : 1.f;
        for (int r = r0; r < r0 + 32; ++r) {
            v4u xn = zero;
            if (r + 1 < seg_hi) xn = *(const v4u*)(RAW + (size_t)(r + 1) * 8192 + c0);
            const Row8 a0 = unpack8(xp), a1 = unpack8(xc), a2 = unpack8(xn);
            float o[8]; float ss = 0.f;
#pragma unroll
            for (int i = 0; i < 8; ++i) { o[i] = siluf(w[0][i] * a0.v[i] + w[1][i] * a1.v[i] + w[2][i] * a2.v[i]); ss += o[i] * o[i]; }
            if (strip < 8) {
                ss += shx(ss, 1, F.lane); ss += shx(ss, 2, F.lane); ss += shx(ss, 4, F.lane); ss += shx(ss, 8, F.lane);
                const float sc = rsqrtf(ss + EPS) * qscale;
#pragma unroll
                for (int i = 0; i < 8; ++i) o[i] *= sc;
            }
            v4u wv; wv.x = pk2(o[0], o[1]); wv.y = pk2(o[2], o[3]); wv.z = pk2(o[4], o[5]); wv.w = pk2(o[6], o[7]);
            *(v4u*)(QKVN + (size_t)r * 8192 + c0) = wv;
            xp = xc; xc = xn;
        }
    }
    for (size_t i = (size_t)blockIdx.x * 512 + F.tid; i < (size_t)MR * 64; i += (size_t)F.G * 512) {
        const int r = (int)(i >> 6), e = (int)(i & 63), dir = e >> 5, hv = e & 31;
        const float gb = GATES[(size_t)r * 128 + dir * 64 + hv], ga = GATES[(size_t)r * 128 + dir * 64 + 32 + hv] + dt_bias[e];
        const float sp = fmaxf(ga, 0.f) + log1pf(expf(-fabsf(ga)));
        BG[i] = 1.f / (1.f + expf(-gb)); BG[(size_t)MR * 64 + i] = -expf(a_log[e]) * sp;
    }
}

__device__ __forceinline__ void dnout_phase(const Frame& F, const float* OF, const float* OR, const bf16* Z, bf16* HM, const float* gn) {
    const int d0 = (F.lane & 15) * 8;
    float g[8];
#pragma unroll
    for (int i = 0; i < 8; ++i) g[i] = gn[d0 + i];
    for (int it = F.gw; it < MR * 8; it += F.NGW) {
        const int r = it >> 3, c0 = (it & 7) * 512 + F.lane * 8;
        const f32x4 a0 = *(const f32x4*)(OF + (size_t)r * 4096 + c0), a1 = *(const f32x4*)(OF + (size_t)r * 4096 + c0 + 4);
        const f32x4 b0 = *(const f32x4*)(OR + (size_t)r * 4096 + c0), b1 = *(const f32x4*)(OR + (size_t)r * 4096 + c0 + 4);
        const Row8 z = unpack8(*(const v4u*)(Z + (size_t)r * 4096 + c0));
        float o[8] = {a0.x + b0.x, a0.y + b0.y, a0.z + b0.z, a0.w + b0.w, a1.x + b1.x, a1.y + b1.y, a1.z + b1.z, a1.w + b1.w};
        float ss = 0.f;
#pragma unroll
        for (int i = 0; i < 8; ++i) ss += o[i] * o[i];
        ss += shx(ss, 1, F.lane); ss += shx(ss, 2, F.lane); ss += shx(ss, 4, F.lane); ss += shx(ss, 8, F.lane);
        const float rs = rsqrtf(ss * (1.f / 128.f) + EPS);
#pragma unroll
        for (int i = 0; i < 8; ++i) o[i] = o[i] * rs * g[i] * siluf(z.v[i]);
        v4u w; w.x = pk2(o[0], o[1]); w.y = pk2(o[2], o[3]); w.z = pk2(o[4], o[5]); w.w = pk2(o[6], o[7]);
        *(v4u*)(HM + (size_t)r * 4096 + c0) = w;
    }
}

__device__ __forceinline__ void final_phase(const Frame& F, const float* X, float* out, const float* gain) {
    f32x4 gv[8];
#pragma unroll
    for (int j = 0; j < 8; ++j) gv[j] = *((const f32x4*)gain + F.lane + 64 * j);
    for (int t = F.gw; t < SEQ; t += F.NGW) {
        const f32x4* xr = (const f32x4*)(X + (size_t)(CTXN + t) * DM) + F.lane; f32x4* orow = (f32x4*)(out + (size_t)t * DM) + F.lane;
        f32x4 v[8]; float ss = 0.f;
#pragma unroll
        for (int j = 0; j < 8; ++j) { v[j] = xr[64 * j]; ss += (v[j].x * v[j].x + v[j].y * v[j].y) + (v[j].z * v[j].z + v[j].w * v[j].w); }
        const float rstd = rsqrtf(wave_sum(ss, F.lane) * (1.f / DM) + EPS);
#pragma unroll
        for (int j = 0; j < 8; ++j) orow[64 * j] = v[j] * rstd * gv[j];
    }
}

__device__ __forceinline__ void dn_recurrent_phase(const Frame& F, const bf16* QKVN, const float* BG, float* OF, float* OR) {
    LAS float* kf = (LAS float*)F.lds; LAS float* qf = kf + 8192; LAS float* vf = qf + 8192; LAS float* gb = vf + 8192; LAS float* ured = gb + 128; LAS float* ored = ured + 512;
    const int j = F.tid & 127, qd = F.tid >> 7;
    for (int item = blockIdx.x; item < 64; item += F.G) {
        const int hv = item >> 1, dir = item & 1, hk = hv >> 1;
        float* O = dir ? OR : OF;
        float S[32];
#pragma unroll
        for (int i = 0; i < 32; ++i) S[i] = 0.f;
        auto row_base = [&](int pc) -> int { return pc < 4 ? (dir ? CTXN - 64 * (pc + 1) : 64 * pc) : CTXN + (dir ? SEQ - 64 * (pc - 3) : 64 * (pc - 4)); };
        v4u sk[2], sq[2], sv[2]; float sg = 0.f;
        auto issue = [&](int pc) { const int rb = row_base(pc);
#pragma unroll
            for (int p = 0; p < 2; ++p) { const int piece = F.tid + 512 * p, rr = piece >> 4, cc = (piece & 15) * 8; const bf16* rp = QKVN + (size_t)(rb + rr) * 8192;
                sk[p] = *(const v4u*)(rp + 2048 + hk * 128 + cc); sq[p] = *(const v4u*)(rp + hk * 128 + cc); sv[p] = *(const v4u*)(rp + 4096 + hv * 128 + cc); }
            if (F.tid < 128) { const int rr = F.tid & 63, which = F.tid >> 6;
                sg = BG[(which ? 0 : (size_t)MR * 64) + (size_t)(rb + rr) * 64 + dir * 32 + hv]; } };
        auto commit = [&]() {
#pragma unroll
            for (int p = 0; p < 2; ++p) { const int piece = F.tid + 512 * p, rr = piece >> 4, cc = (piece & 15) * 8; const Row8 a = unpack8(sk[p]), b = unpack8(sq[p]), c = unpack8(sv[p]);
#pragma unroll
                for (int i = 0; i < 8; ++i) { kf[rr * 128 + cc + i] = a.v[i]; qf[rr * 128 + cc + i] = b.v[i]; vf[rr * 128 + cc + i] = c.v[i]; } }
            if (F.tid < 128) gb[F.tid] = sg; };
        issue(0);
        int par = 0; int prev_row = -1;
        for (int pc = 0; pc < 260; ++pc) {
            __syncthreads();
            commit();
            __syncthreads();
            if (pc + 1 < 260) issue(pc + 1);
            const int rb = row_base(pc);
            for (int tt = 0; tt < 64; ++tt) {
                const int lr = dir ? 63 - tt : tt;
                const LAS f32x4* k4 = (const LAS f32x4*)(kf + lr * 128 + qd * 32); const LAS f32x4* q4 = (const LAS f32x4*)(qf + lr * 128 + qd * 32);
                float kk[32];
                float up = 0.f;
#pragma unroll
                for (int i = 0; i < 8; ++i) { const f32x4 t = k4[i]; kk[4 * i] = t.x; kk[4 * i + 1] = t.y; kk[4 * i + 2] = t.z; kk[4 * i + 3] = t.w; }
#pragma unroll
                for (int i = 0; i < 32; ++i) up += S[i] * kk[i];
                ured[qd * 128 + j] = up;
                __syncthreads();
                if (qd == 0 && prev_row >= 0) {
                    const LAS float* op = ored + (par ^ 1) * 512 + j; O[(size_t)prev_row * 4096 + hv * 128 + j] = (op[0] + op[128]) + (op[256] + op[384]); }
                const float u = (ured[j] + ured[128 + j]) + (ured[256 + j] + ured[384 + j]);
                const float eg = __expf(gb[lr]), beta = gb[64 + lr];
                const float vnew = beta * (vf[lr * 128 + j] - eg * u);
                float opart = 0.f;
#pragma unroll
                for (int i = 0; i < 8; ++i) { const f32x4 t = q4[i];
                    S[4 * i] = S[4 * i] * eg + kk[4 * i] * vnew; S[4 * i + 1] = S[4 * i + 1] * eg + kk[4 * i + 1] * vnew; S[4 * i + 2] = S[4 * i + 2] * eg + kk[4 * i + 2] * vnew; S[4 * i + 3] = S[4 * i + 3] * eg + kk[4 * i + 3] * vnew;
                    opart += S[4 * i] * t.x + S[4 * i + 1] * t.y + S[4 * i + 2] * t.z + S[4 * i + 3] * t.w; }
                ored[par * 512 + qd * 128 + j] = opart;
                prev_row = rb + lr; par ^= 1;
                __syncthreads();
            }
        }
        if (qd == 0) { const LAS float* op = ored + (par ^ 1) * 512 + j; O[(size_t)prev_row * 4096 + hv * 128 + j] = (op[0] + op[128]) + (op[256] + op[384]); }
        __syncthreads();
    }
}

constexpr int NCB = MR / 64;
constexpr int ITEM_W = 0, ITEM_AQK = 16384, ITEM_U = 24576, ITEM_TAB = 40960, ITEM_BYTES = 41984;
typedef short bf16x8_t __attribute__((ext_vector_type(8)));
typedef float f32x16_t __attribute__((ext_vector_type(16)));
__device__ __forceinline__ int crow16(int r, int hi) { return (r & 3) + 8 * (r >> 2) + 4 * hi; }
__device__ __forceinline__ bf16x8_t as_frag(v4u x) { return __builtin_bit_cast(bf16x8_t, x); }

__device__ __forceinline__ void dnconv2_phase(const Frame& F, const bf16* RAW, bf16* QKrm, unsigned char* QF, unsigned char* KT, unsigned char* VT,
                                              const float* cw, const float* GATES, float* BG, const float* a_log, const float* dt_bias) {
    constexpr int NSTRIP = 8192 / 512, NRUN = MR / 32;
    const int Lp = F.lane & 15, hd = F.lane >> 4;
    for (int it = F.gw; it < NSTRIP * NRUN; it += F.NGW) {
        const int strip = it % NSTRIP, run = it / NSTRIP, c0 = strip * 512 + F.lane * 8, r0 = run * 32;
        const int seg_lo = r0 < CTXN ? 0 : CTXN, seg_hi = r0 < CTXN ? CTXN : MR;
        const int cb = run >> 1;
        float w[3][8];
#pragma unroll
        for (int t = 0; t < 3; ++t)
#pragma unroll
            for (int i = 0; i < 8; ++i) w[t][i] = cw[t * 8192 + c0 + i];
        const v4u zero = (v4u){0u, 0u, 0u, 0u};
        const float qscale = strip < 4 ? 0.088388347648318440f : 1.f;
        unsigned char* tbase = nullptr;
        if (strip >= 4 && strip < 8) tbase = KT + ((size_t)cb * 16 + (strip - 4) * 4 + hd) * 16384;
        if (strip >= 8) tbase = VT + ((size_t)cb * 32 + (strip - 8) * 4 + hd) * 16384;
        unsigned char* qbase = QF + ((size_t)cb * 16 + strip * 4 + hd) * 16384;
#pragma unroll 1
        for (int g = 0; g < 2; ++g) {
            unsigned pk[8][8]; float prev[8];
            v4u xr[18];
#pragma unroll
            for (int k = 0; k < 18; ++k) { const int rk = r0 + g * 16 - 1 + k; xr[k] = (rk >= seg_lo && rk < seg_hi) ? *(const v4u*)(RAW + (size_t)rk * 8192 + c0) : zero; }
#pragma unroll
            for (int rr = 0; rr < 16; ++rr) {
                const int r = r0 + g * 16 + rr;
                const Row8 a0 = unpack8(xr[rr]), a1 = unpack8(xr[rr + 1]), a2 = unpack8(xr[rr + 2]);
                float o[8]; float ss = 0.f;
#pragma unroll
                for (int i = 0; i < 8; ++i) { o[i] = siluf(w[0][i] * a0.v[i] + w[1][i] * a1.v[i] + w[2][i] * a2.v[i]); ss += o[i] * o[i]; }
                if (strip < 8) {
                    ss += shx(ss, 1, F.lane); ss += shx(ss, 2, F.lane); ss += shx(ss, 4, F.lane); ss += shx(ss, 8, F.lane);
                    const float sc = rsqrtf(ss + EPS) * qscale;
#pragma unroll
                    for (int i = 0; i < 8; ++i) o[i] *= sc;
                    v4u wv; wv.x = pk2(o[0], o[1]); wv.y = pk2(o[2], o[3]); wv.z = pk2(o[4], o[5]); wv.w = pk2(o[6], o[7]);
                    *(v4u*)(QKrm + (size_t)r * 4096 + c0) = wv;
                    if (strip < 4) {
                        const int rl = r & 63, mt = rl >> 5, r32 = rl & 31, f = (mt * 4 + (Lp >> 2)) * 2 + ((Lp >> 1) & 1);
                        unsigned char* d = qbase + f * 1024 + r32 * 16 + (Lp & 1) * 8;
                        *(v2u*)(d) = (v2u){wv.x, wv.y}; *(v2u*)(d + 512) = (v2u){wv.z, wv.w};
                    }
                }
                if (strip >= 4) {
                    if (rr & 1) {
#pragma unroll
                        for (int i = 0; i < 8; ++i) pk[i][rr >> 1] = pk2(prev[i], o[i]);
                    } else {
#pragma unroll
                        for (int i = 0; i < 8; ++i) prev[i] = o[i];
                    }
                }
            }
            if (strip >= 4) {
                const int q = (run & 1) * 2 + g, f = ((Lp >> 2) * 2 + (q >> 1)) * 2 + (q & 1);
                unsigned char* d = tbase + f * 1024 + (8 * (Lp & 3)) * 16;
#pragma unroll
                for (int i = 0; i < 8; ++i) {
                    *(v4u*)(d + i * 16) = (v4u){pk[i][0], pk[i][1], pk[i][4], pk[i][5]};
                    *(v4u*)(d + 512 + i * 16) = (v4u){pk[i][2], pk[i][3], pk[i][6], pk[i][7]};
                }
            }
        }
    }
    for (size_t i = (size_t)blockIdx.x * 512 + F.tid; i < (size_t)MR * 64; i += (size_t)F.G * 512) {
        const int r = (int)(i >> 6), e = (int)(i & 63), dir = e >> 5, hv = e & 31;
        const float gb = GATES[(size_t)r * 128 + dir * 64 + hv], ga = GATES[(size_t)r * 128 + dir * 64 + 32 + hv] + dt_bias[e];
        const float sp = fmaxf(ga, 0.f) + log1pf(expf(-fabsf(ga)));
        BG[i] = 1.f / (1.f + expf(-gb)); BG[(size_t)MR * 64 + i] = -expf(a_log[e]) * sp;
    }
}

constexpr int DK_REGION = 17920;
constexpr int TROW = 136;
__device__ __forceinline__ void dk_phase(const Frame& F, const bf16* QKrm, const unsigned char* KT, const unsigned char* VT, const float* BG, unsigned char* ITEMS) {
    LAS unsigned char* reg = F.lds + F.wave * DK_REGION;
    LAS float* Amat = (LAS float*)reg; LAS unsigned char* TW = reg; LAS unsigned char* TU = reg + 64 * TROW;
    LAS float* gamL = (LAS float*)(reg + 17408); LAS float* betaL = gamL + 64;
    for (int it = F.gw; it < NCB * 64; it += F.NGW) {
        int lane_l = F.lane; asm volatile("" : "+v"(lane_l));
        const int lane = lane_l, r32 = lane & 31, hi = lane >> 5;
        const int cb = it >> 6, hv = (it >> 1) & 31, dir = it & 1, hk = hv >> 1;
        unsigned char* item = ITEMS + (size_t)it * ITEM_BYTES;
        const int row0 = cb * 64;
        const float gl = BG[(size_t)MR * 64 + (size_t)(row0 + lane) * 64 + dir * 32 + hv], bl = BG[(size_t)(row0 + lane) * 64 + dir * 32 + hv];
        float gam = gl;
        if (dir == 0) {
#pragma unroll
            for (int o = 1; o < 64; o <<= 1) { const float t = shl_from(gam, lane - o); if (lane >= o) gam += t; }
        } else {
#pragma unroll
            for (int o = 1; o < 64; o <<= 1) { const float t = shl_from(gam, lane + o); if (lane + o < 64) gam += t; }
        }
        const float last = shl_from(gam, dir ? 0 : 63);
        gamL[lane] = gam; betaL[lane] = bl;
        {
            const int w = lane & 31, idx = ((lane >> 5) * 2 + ((w >> 2) & 1)) * 16 + (w & 3) + 4 * (w >> 3);
            float* tab = (float*)(item + ITEM_TAB);
            tab[idx] = __expf(gam); tab[64 + idx] = __expf(last - gam); if (lane == 0) tab[128] = __expf(last);
        }
        LDS_WAIT();
        const bf16* Kb = QKrm + (size_t)row0 * 4096 + 2048 + hk * 128 + 8 * hi;
        const bf16* Qb = QKrm + (size_t)row0 * 4096 + hk * 128 + 8 * hi;
        bf16x8_t Kn[2][8];
#pragma unroll
        for (int mi = 0; mi < 2; ++mi)
#pragma unroll
            for (int ks = 0; ks < 8; ++ks) Kn[mi][ks] = as_frag(*(const v4u*)(Kb + (size_t)(32 * mi + r32) * 4096 + 16 * ks));
        {
            f32x16_t kk[2][2];
#pragma unroll
            for (int mi = 0; mi < 2; ++mi)
#pragma unroll
                for (int ni = 0; ni < 2; ++ni) { kk[mi][ni] = f32x16_t{};
#pragma unroll
                    for (int ks = 0; ks < 8; ++ks) kk[mi][ni] = __builtin_amdgcn_mfma_f32_32x32x16_bf16(Kn[mi][ks], Kn[ni][ks], kk[mi][ni], 0, 0, 0); }
#pragma unroll
            for (int ni = 0; ni < 2; ++ni) { const int s = 32 * ni + r32; const float gs = gamL[s]; const int sp = dir ? 63 - s : s;
#pragma unroll
                for (int mi = 0; mi < 2; ++mi)
#pragma unroll
                    for (int rg = 0; rg < 16; ++rg) { const int r = 32 * mi + crow16(rg, hi); const int rp = dir ? 63 - r : r;
                        const float gr = gamL[r], br = betaL[r];
                        const float v = (sp < rp) ? br * kk[mi][ni][rg] * __expf(gr - gs) : 0.f;
                        Amat[rp * 64 + sp] = v; } }
        }
        asm volatile("" ::: "memory"); __builtin_amdgcn_sched_barrier(0);
        {
            bf16x8_t Qn[2][8];
#pragma unroll
            for (int mi = 0; mi < 2; ++mi)
#pragma unroll
                for (int ks = 0; ks < 8; ++ks) Qn[mi][ks] = as_frag(*(const v4u*)(Qb + (size_t)(32 * mi + r32) * 4096 + 16 * ks));
#pragma unroll
            for (int ri = 0; ri < 2; ++ri) { const int r = 32 * ri + r32; const float gr = gamL[r];
#pragma unroll
                for (int si = 0; si < 2; ++si) { f32x16_t p = f32x16_t{};
#pragma unroll
                    for (int ks = 0; ks < 8; ++ks) p = __builtin_amdgcn_mfma_f32_32x32x16_bf16(Kn[si][ks], Qn[ri][ks], p, 0, 0, 0);
                    float pv[16];
#pragma unroll
                    for (int rg = 0; rg < 16; ++rg) { const int s = 32 * si + crow16(rg, hi); const float gs = gamL[s];
                        const bool ok = dir ? (s >= r) : (s <= r);
                        pv[rg] = ok ? p[rg] * __expf(gr - gs) : 0.f; }
#pragma unroll
                    for (int st = 0; st < 2; ++st) { v4u wv; wv.x = pk2(pv[8 * st + 0], pv[8 * st + 1]); wv.y = pk2(pv[8 * st + 2], pv[8 * st + 3]); wv.z = pk2(pv[8 * st + 4], pv[8 * st + 5]); wv.w = pk2(pv[8 * st + 6], pv[8 * st + 7]);
                        *(v4u*)(item + ITEM_AQK + ((ri * 2 + si) * 2 + st) * 1024 + lane * 16) = wv; } } }
        }
        LDS_WAIT();
        asm volatile("" ::: "memory"); __builtin_amdgcn_sched_barrier(0);
        float t[64];
#pragma unroll
        for (int r = 0; r < 64; ++r) {
            float acc = (lane == r) ? 1.f : 0.f;
#pragma unroll
            for (int s4 = 0; s4 < (r + 3) / 4; ++s4) { const f32x4 a = *(const LAS f32x4*)(Amat + r * 64 + 4 * s4);
                if (4 * s4 + 0 < r) acc -= a.x * t[4 * s4 + 0]; if (4 * s4 + 1 < r) acc -= a.y * t[4 * s4 + 1];
                if (4 * s4 + 2 < r) acc -= a.z * t[4 * s4 + 2]; if (4 * s4 + 3 < r) acc -= a.w * t[4 * s4 + 3]; }
            t[r] = acc;
        }
        asm volatile("" ::: "memory"); __builtin_amdgcn_sched_barrier(0);
        {
            const int c = dir ? 63 - lane : lane; const float bc = betaL[c], wc = bc * __expf(gamL[c]);
            asm volatile("s_waitcnt lgkmcnt(0)" ::: "memory");
#pragma unroll
            for (int rp = 0; rp < 64; ++rp) { const int r = dir ? 63 - rp : rp;
                const unsigned w2 = pk2(t[rp] * wc, t[rp] * bc);
                *(LAS unsigned short*)(TW + r * TROW + c * 2) = (unsigned short)(w2 & 0xffffu);
                *(LAS unsigned short*)(TU + r * TROW + c * 2) = (unsigned short)(w2 >> 16); }
        }
        LDS_WAIT();
        asm volatile("" ::: "memory"); __builtin_amdgcn_sched_barrier(0);
        const unsigned char* ktb = KT + ((size_t)cb * 16 + hk) * 16384;
        const unsigned char* vtb = VT + ((size_t)cb * 32 + hv) * 16384;
#pragma unroll
        for (int mt = 0; mt < 2; ++mt) {
            bf16x8_t tb[2][2];
#pragma unroll
            for (int tt = 0; tt < 2; ++tt)
#pragma unroll
                for (int s = 0; s < 2; ++s) { const LAS unsigned char* p = TW + (32 * mt + r32) * TROW + (32 * tt + 16 * s + 4 * hi) * 2;
                    const v2u lo = *(const LAS v2u*)p, hi2 = *(const LAS v2u*)(p + 16); tb[tt][s] = as_frag((v4u){lo.x, lo.y, hi2.x, hi2.y}); }
            bf16x8_t gf[16];
#pragma unroll
            for (int k = 0; k < 16; ++k) gf[k] = as_frag(*(const v4u*)(ktb + k * 1024 + lane * 16));
            asm volatile("s_waitcnt vmcnt(0)" ::: "memory"); __builtin_amdgcn_sched_barrier(0);
#pragma unroll
            for (int dt = 0; dt < 4; ++dt) { f32x16_t acc = f32x16_t{};
#pragma unroll
                for (int tt = 0; tt < 2; ++tt)
#pragma unroll
                    for (int s = 0; s < 2; ++s) { const bf16x8_t a = gf[(dt * 2 + tt) * 2 + s];
                        acc = __builtin_amdgcn_mfma_f32_32x32x16_bf16(a, tb[tt][s], acc, 0, 0, 0); }
#pragma unroll
                for (int st = 0; st < 2; ++st) { v4u wv; wv.x = pk2(acc[8 * st + 0], acc[8 * st + 1]); wv.y = pk2(acc[8 * st + 2], acc[8 * st + 3]); wv.z = pk2(acc[8 * st + 4], acc[8 * st + 5]); wv.w = pk2(acc[8 * st + 6], acc[8 * st + 7]);
                    *(v4u*)(item + ITEM_W + ((mt * 4 + dt) * 2 + st) * 1024 + lane * 16) = wv; } }
            bf16x8_t ta[2][2];
#pragma unroll
            for (int tt = 0; tt < 2; ++tt)
#pragma unroll
                for (int s = 0; s < 2; ++s) { const LAS unsigned char* p = TU + (32 * mt + r32) * TROW + (32 * tt + 16 * s + 4 * hi) * 2;
                    const v2u lo = *(const LAS v2u*)p, hi2 = *(const LAS v2u*)(p + 16); ta[tt][s] = as_frag((v4u){lo.x, lo.y, hi2.x, hi2.y}); }
#pragma unroll
            for (int k = 0; k < 16; ++k) gf[k] = as_frag(*(const v4u*)(vtb + k * 1024 + lane * 16));
            asm volatile("s_waitcnt vmcnt(0)" ::: "memory"); __builtin_amdgcn_sched_barrier(0);
#pragma unroll
            for (int vt = 0; vt < 4; ++vt) { f32x16_t acc = f32x16_t{};
#pragma unroll
                for (int tt = 0; tt < 2; ++tt)
#pragma unroll
                    for (int s = 0; s < 2; ++s) { const bf16x8_t b = gf[(vt * 2 + tt) * 2 + s];
                        acc = __builtin_amdgcn_mfma_f32_32x32x16_bf16(ta[tt][s], b, acc, 0, 0, 0); }
                v4u w0, w1; w0.x = pk2(acc[0], acc[1]); w0.y = pk2(acc[2], acc[3]); w0.z = pk2(acc[4], acc[5]); w0.w = pk2(acc[6], acc[7]);
                w1.x = pk2(acc[8], acc[9]); w1.y = pk2(acc[10], acc[11]); w1.z = pk2(acc[12], acc[13]); w1.w = pk2(acc[14], acc[15]);
                unsigned char* d = item + ITEM_U + (vt * 2 + mt) * 2048 + lane * 32;
                *(v4u*)d = w0; *(v4u*)(d + 16) = w1; }
        }
        LDS_WAIT();
    }
}

constexpr int ST_W = 0, ST_QF = 16384, ST_AQK = 32768, ST_KT = 40960, ST_U = 57344, ST_TAB = 61440, ST_BYTES = 62464;
constexpr int DS_SBUF = 2 * ST_BYTES, DS_XBUF = DS_SBUF + 2 * 8192, DS_OBUF = DS_XBUF + 2 * 4096, DS_END = DS_OBUF + 2 * 4096;
#define DS_BAR() asm volatile("s_waitcnt vmcnt(0) lgkmcnt(0)\n\ts_barrier" ::: "memory")
#define DS_CB(pc) (dir ? ((pc) < 4 ? 3 - (pc) : 263 - (pc)) : (pc))
#define DS_LD4(bank, base) do { _Pragma("unroll") for (int i_ = 0; i_ < 4; ++i_) bank[i_] = as_frag(*(const LAS v4u*)((base) + i_ * 1024 + lane * 16)); } while (0)
#define DS_WAITL(n) do { asm volatile("s_waitcnt lgkmcnt(" #n ")" ::: "memory"); __builtin_amdgcn_sched_barrier(0); } while (0)
#define DS_SB() __builtin_amdgcn_sched_barrier(0)
#define DS_MM4(acc, bank, bop, o) do { _Pragma("unroll") for (int k_ = 0; k_ < 4; ++k_) acc = __builtin_amdgcn_mfma_f32_32x32x16_bf16(bank[k_], bop[(o) + k_], acc, 0, 0, 0); } while (0)
__device__ __forceinline__ void ds_role_state(LAS unsigned char* lds, int lane_in) {
    int lane = lane_in; asm volatile("" : "+v"(lane));
    const int hi = lane >> 5;
    f32x16_t Sacc[4]; bf16x8_t sb[8];
#pragma unroll
    for (int d = 0; d < 4; ++d) Sacc[d] = f32x16_t{};
#pragma unroll
    for (int k = 0; k < 8; ++k) { sb[k] = bf16x8_t{}; *(LAS v4u*)(lds + DS_SBUF + k * 1024 + lane * 16) = (v4u){0u, 0u, 0u, 0u}; }
    DS_BAR();
#pragma unroll 1
    for (int pc = 0; pc < NCB; ++pc) {
        const int bsel = pc & 1; LAS unsigned char* st = lds + bsel * ST_BYTES;
        const LAS float* tab = (const LAS float*)(st + ST_TAB);
        bf16x8_t f0[4], f1[4], vy[4];
        float el;
        {
            f32x16_t ws0 = f32x16_t{}, ws1 = f32x16_t{};
            DS_LD4(f0, st + ST_W); DS_SB();
            DS_LD4(f1, st + ST_W + 4096); DS_WAITL(4); DS_MM4(ws0, f0, sb, 0); DS_SB();
            DS_LD4(f0, st + ST_W + 8192); DS_WAITL(4); DS_MM4(ws0, f1, sb, 4); DS_SB();
            DS_LD4(f1, st + ST_W + 12288); DS_WAITL(4); DS_MM4(ws1, f0, sb, 0); DS_SB();
            DS_WAITL(0); DS_MM4(ws1, f1, sb, 4); DS_SB();
            DS_LD4(f0, st + ST_KT); DS_SB();
            el = tab[128];
#pragma unroll
            for (int mt = 0; mt < 2; ++mt) {
                const LAS v4u* up = (const LAS v4u*)(st + ST_U + mt * 2048 + lane * 32); const v4u u0 = up[0], u1 = up[1];
                const unsigned uu[8] = {u0.x, u0.y, u0.z, u0.w, u1.x, u1.y, u1.z, u1.w};
                float vn[16], vs2[16];
                const LAS f32x4* elg4 = (const LAS f32x4*)(tab + 64 + (mt * 2 + hi) * 16);
#pragma unroll
                for (int q4 = 0; q4 < 4; ++q4) { const f32x4 e = elg4[q4]; const float w0 = mt ? ws1[4 * q4 + 0] : ws0[4 * q4 + 0], w1 = mt ? ws1[4 * q4 + 1] : ws0[4 * q4 + 1], w2 = mt ? ws1[4 * q4 + 2] : ws0[4 * q4 + 2], w3 = mt ? ws1[4 * q4 + 3] : ws0[4 * q4 + 3];
                    vn[4 * q4 + 0] = bflo(uu[2 * q4]) - w0; vn[4 * q4 + 1] = bfhi(uu[2 * q4]) - w1; vn[4 * q4 + 2] = bflo(uu[2 * q4 + 1]) - w2; vn[4 * q4 + 3] = bfhi(uu[2 * q4 + 1]) - w3;
                    vs2[4 * q4 + 0] = vn[4 * q4 + 0] * e.x; vs2[4 * q4 + 1] = vn[4 * q4 + 1] * e.y; vs2[4 * q4 + 2] = vn[4 * q4 + 2] * e.z; vs2[4 * q4 + 3] = vn[4 * q4 + 3] * e.w; }
#pragma unroll
                for (int s = 0; s < 2; ++s) {
                    v4u xv; xv.x = pk2(vn[8 * s + 0], vn[8 * s + 1]); xv.y = pk2(vn[8 * s + 2], vn[8 * s + 3]); xv.z = pk2(vn[8 * s + 4], vn[8 * s + 5]); xv.w = pk2(vn[8 * s + 6], vn[8 * s + 7]);
                    *(LAS v4u*)(lds + DS_XBUF + bsel * 4096 + (mt * 2 + s) * 1024 + lane * 16) = xv;
                    v4u yv; yv.x = pk2(vs2[8 * s + 0], vs2[8 * s + 1]); yv.y = pk2(vs2[8 * s + 2], vs2[8 * s + 3]); yv.z = pk2(vs2[8 * s + 4], vs2[8 * s + 5]); yv.w = pk2(vs2[8 * s + 6], vs2[8 * s + 7]);
                    vy[mt * 2 + s] = as_frag(yv); }
            }
        }
        DS_SB();
        DS_LD4(f1, st + ST_KT + 4096); DS_WAITL(4);
        Sacc[0] = Sacc[0] * el; DS_MM4(Sacc[0], f0, vy, 0); DS_SB();
        DS_LD4(f0, st + ST_KT + 8192); DS_WAITL(4);
        Sacc[1] = Sacc[1] * el; DS_MM4(Sacc[1], f1, vy, 0); DS_SB();
        DS_LD4(f1, st + ST_KT + 12288); DS_WAITL(4);
        Sacc[2] = Sacc[2] * el; DS_MM4(Sacc[2], f0, vy, 0); DS_SB();
        DS_WAITL(0);
        Sacc[3] = Sacc[3] * el; DS_MM4(Sacc[3], f1, vy, 0); DS_SB();
#pragma unroll
        for (int d = 0; d < 4; ++d)
#pragma unroll
            for (int s = 0; s < 2; ++s) { v4u sv; sv.x = pk2(Sacc[d][8 * s + 0], Sacc[d][8 * s + 1]); sv.y = pk2(Sacc[d][8 * s + 2], Sacc[d][8 * s + 3]); sv.z = pk2(Sacc[d][8 * s + 4], Sacc[d][8 * s + 5]); sv.w = pk2(Sacc[d][8 * s + 6], Sacc[d][8 * s + 7]);
                sb[d * 2 + s] = as_frag(sv);
                *(LAS v4u*)(lds + DS_SBUF + (bsel ^ 1) * 8192 + (d * 2 + s) * 1024 + lane * 16) = sv; }
        DS_BAR();
    }
    DS_BAR();
}
__device__ __forceinline__ void ds_role_out(LAS unsigned char* lds, int lane_in) {
    int lane = lane_in; asm volatile("" : "+v"(lane));
    const int hi = lane >> 5;
    f32x16_t po0 = f32x16_t{}, po1 = f32x16_t{}; bf16x8_t aq[8];
#pragma unroll
    for (int k = 0; k < 8; ++k) aq[k] = bf16x8_t{};
    DS_BAR();
#pragma unroll 1
    for (int pc = 0; pc <= NCB; ++pc) {
        const int bsel = pc & 1; LAS unsigned char* st = lds + bsel * ST_BYTES;
        if (pc > 0) {
            bf16x8_t vx[4];
            DS_LD4(vx, lds + DS_XBUF + (bsel ^ 1) * 4096); DS_WAITL(0);
            DS_MM4(po0, aq, vx, 0);
#pragma unroll
            for (int k = 0; k < 4; ++k) po1 = __builtin_amdgcn_mfma_f32_32x32x16_bf16(aq[4 + k], vx[k], po1, 0, 0, 0);
            DS_SB();
            LAS unsigned short* ob = (LAS unsigned short*)(lds + DS_OBUF + bsel * 4096);
#pragma unroll
            for (int rg = 0; rg < 16; rg += 2) { const unsigned w2 = pk2(po0[rg], po0[rg + 1]), w3 = pk2(po1[rg], po1[rg + 1]);
                ob[(crow16(rg, hi)) * 32 + (lane & 31)] = (unsigned short)(w2 & 0xffffu); ob[(crow16(rg + 1, hi)) * 32 + (lane & 31)] = (unsigned short)(w2 >> 16);
                ob[(32 + crow16(rg, hi)) * 32 + (lane & 31)] = (unsigned short)(w3 & 0xffffu); ob[(32 + crow16(rg + 1, hi)) * 32 + (lane & 31)] = (unsigned short)(w3 >> 16); }
        }
        if (pc < NCB) {
            const LAS float* tab = (const LAS float*)(st + ST_TAB);
            bf16x8_t sf[8], f0[4], f1[4];
#pragma unroll
            for (int k = 0; k < 8; ++k) sf[k] = as_frag(*(const LAS v4u*)(lds + DS_SBUF + bsel * 8192 + k * 1024 + lane * 16));
            DS_LD4(f0, st + ST_QF); DS_SB();
            po0 = f32x16_t{}; po1 = f32x16_t{};
            DS_LD4(f1, st + ST_QF + 4096); DS_WAITL(4); DS_MM4(po0, f0, sf, 0); DS_SB();
            DS_LD4(f0, st + ST_QF + 8192); DS_WAITL(4); DS_MM4(po0, f1, sf, 4); DS_SB();
            DS_LD4(f1, st + ST_QF + 12288); DS_WAITL(4); DS_MM4(po1, f0, sf, 0); DS_SB();
            DS_WAITL(0); DS_MM4(po1, f1, sf, 4); DS_SB();
#pragma unroll
            for (int k = 0; k < 8; ++k) aq[k] = as_frag(*(const LAS v4u*)(st + ST_AQK + k * 1024 + lane * 16));
            const LAS f32x4* eg40 = (const LAS f32x4*)(tab + (0 * 2 + hi) * 16); const LAS f32x4* eg41 = (const LAS f32x4*)(tab + (1 * 2 + hi) * 16);
#pragma unroll
            for (int q4 = 0; q4 < 4; ++q4) { const f32x4 g0 = eg40[q4], g1 = eg41[q4];
                po0[4 * q4 + 0] *= g0.x; po0[4 * q4 + 1] *= g0.y; po0[4 * q4 + 2] *= g0.z; po0[4 * q4 + 3] *= g0.w;
                po1[4 * q4 + 0] *= g1.x; po1[4 * q4 + 1] *= g1.y; po1[4 * q4 + 2] *= g1.z; po1[4 * q4 + 3] *= g1.w; }
        }
        DS_BAR();
    }
}
__device__ __forceinline__ void ds_role_load(LAS unsigned char* lds, int lt, const unsigned char* ITEMS, const unsigned char* QF, const unsigned char* KT, bf16* Od, int hv, int hk, int dir, int vs) {
    const int lw = __builtin_amdgcn_readfirstlane(lt >> 6), g = lw >> 1, wg = lw & 1, ll = lt & 63;
    v4u tr[31];
#define DS_ISSUE(pc) do { const int cb_ = DS_CB(pc); const unsigned char* item_ = ITEMS + ((size_t)(cb_ * 32 + hv) * 2 + dir) * ITEM_BYTES + (size_t)wg * 1024 + ll * 16; \
        const unsigned char* qf_ = QF + ((size_t)cb_ * 16 + hk) * 16384 + (size_t)wg * 1024 + ll * 16; const unsigned char* kt_ = KT + ((size_t)cb_ * 16 + hk) * 16384 + (size_t)wg * 1024 + ll * 16; \
        _Pragma("unroll") for (int k_ = 0; k_ < 8; ++k_) tr[k_] = *(const v4u*)(item_ + k_ * 2048); \
        _Pragma("unroll") for (int k_ = 0; k_ < 8; ++k_) tr[8 + k_] = *(const v4u*)(qf_ + k_ * 2048); \
        _Pragma("unroll") for (int k_ = 0; k_ < 4; ++k_) tr[16 + k_] = *(const v4u*)(item_ + ITEM_AQK + k_ * 2048); \
        _Pragma("unroll") for (int k_ = 0; k_ < 8; ++k_) tr[20 + k_] = *(const v4u*)(kt_ + k_ * 2048); \
        _Pragma("unroll") for (int k_ = 0; k_ < 2; ++k_) tr[28 + k_] = *(const v4u*)(item_ + ITEM_U + vs * 4096 + k_ * 2048); \
        if (wg == 0) tr[30] = *(const v4u*)(item_ + ITEM_TAB); } while (0)
#define DS_COMMIT(buf) do { LAS unsigned char* d_ = lds + (buf) * ST_BYTES + wg * 1024 + ll * 16; \
        _Pragma("unroll") for (int k_ = 0; k_ < 30; ++k_) *(LAS v4u*)(d_ + k_ * 2048) = tr[k_]; \
        if (wg == 0) *(LAS v4u*)(d_ + 61440) = tr[30]; } while (0)
#define DS_BAR_L() asm volatile("s_waitcnt lgkmcnt(0)\n\ts_barrier" ::: "memory")
    int ncs;
    if (g == 0) { DS_ISSUE(0); DS_COMMIT(0); DS_ISSUE(3); ncs = 2; }
    else if (g == 1) { DS_ISSUE(1); ncs = 0; }
    else { DS_ISSUE(2); ncs = 1; }
    DS_BAR_L();
#pragma unroll 1
    for (int pc = 0; pc <= NCB; ++pc) {
        if (pc == ncs) {
            if (pc + 1 < NCB) DS_COMMIT((pc + 1) & 1);
            if (pc + 4 < NCB) DS_ISSUE(pc + 4);
            ncs += 3;
        }
        if (pc >= 2 && (pc % 3) == g) {
            const int cbo = DS_CB(pc - 2);
#pragma unroll
            for (int k = 0; k < 2; ++k) { const int f = wg + 2 * k, rr = f * 16 + (ll >> 2), pz = ll & 3;
                const v4u v = *(const LAS v4u*)(lds + DS_OBUF + ((pc & 1) ^ 1) * 4096 + rr * 64 + pz * 16);
                *(v4u*)(Od + (size_t)(cbo * 64 + rr) * 4096 + pz * 8) = v; }
        }
        DS_BAR_L();
    }
    if (g == 0) {
        const int cbo = DS_CB(NCB - 1);
#pragma unroll
        for (int k = 0; k < 2; ++k) { const int f = wg + 2 * k, rr = f * 16 + (ll >> 2), pz = ll & 3;
            const v4u v = *(const LAS v4u*)(lds + DS_OBUF + (NCB & 1) * 4096 + rr * 64 + pz * 16);
            *(v4u*)(Od + (size_t)(cbo * 64 + rr) * 4096 + pz * 8) = v; }
    }
#undef DS_ISSUE
#undef DS_COMMIT
#undef DS_BAR_L
}
__device__ __forceinline__ void ds_phase(const Frame& F, const unsigned char* ITEMS, const unsigned char* QF, const unsigned char* KT, bf16* O) {
    for (int b = blockIdx.x; b < 256; b += F.G) {
        const int hk_dir = (b & 7) * 4 + ((b >> 3) >> 3), sub = (b >> 3) & 7;
        const int hk = hk_dir >> 1, dir = hk_dir & 1, hv = 2 * hk + (sub >> 2), vs = sub & 3;
        bf16* Od = O + (size_t)dir * MR * 4096 + hv * 128 + vs * 32;
        if (F.wave == 0) ds_role_state(F.lds, F.lane);
        else if (F.wave == 1) ds_role_out(F.lds, F.lane);
        else ds_role_load(F.lds, F.tid - 128, ITEMS, QF, KT, Od, hv, hk, dir, vs);
        DS_BAR();
    }
}
#undef DS_BAR
#undef DS_CB
#undef DS_LD4
#undef DS_WAITL
#undef DS_SB
#undef DS_MM4

__device__ __forceinline__ void dnout2_phase(const Frame& F, const bf16* O, const bf16* Z, bf16* HM, const float* gn) {
    const int d0 = (F.lane & 15) * 8;
    float g[8];
#pragma unroll
    for (int i = 0; i < 8; ++i) g[i] = gn[d0 + i];
    for (int it = F.gw; it < MR * 8; it += F.NGW) {
        const int r = it >> 3, c0 = (it & 7) * 512 + F.lane * 8;
        const Row8 a = unpack8(*(const v4u*)(O + (size_t)r * 4096 + c0)), bq = unpack8(*(const v4u*)(O + (size_t)MR * 4096 + (size_t)r * 4096 + c0));
        const Row8 z = unpack8(*(const v4u*)(Z + (size_t)r * 4096 + c0));
        float o[8]; float ss = 0.f;
#pragma unroll
        for (int i = 0; i < 8; ++i) { o[i] = a.v[i] + bq.v[i]; ss += o[i] * o[i]; }
        ss += shx(ss, 1, F.lane); ss += shx(ss, 2, F.lane); ss += shx(ss, 4, F.lane); ss += shx(ss, 8, F.lane);
        const float rs = rsqrtf(ss * (1.f / 128.f) + EPS);
#pragma unroll
        for (int i = 0; i < 8; ++i) o[i] = o[i] * rs * g[i] * siluf(z.v[i]);
        v4u w; w.x = pk2(o[0], o[1]); w.y = pk2(o[2], o[3]); w.z = pk2(o[4], o[5]); w.w = pk2(o[6], o[7]);
        *(v4u*)(HM + (size_t)r * 4096 + c0) = w;
    }
}
#ifndef ATT_SD
#define ATT_SD 1
#endif

__device__ __forceinline__ void diffattn_phase(const Frame& F, const bf16* QKV, float* OA) {
    char* lds = (char*)(unsigned char*)F.lds;
    const int c = blockIdx.x;
    for (int i = 0; ; ++i) {
        int combo, row0, nt;
        if (F.G == 256) { if (i < 4) { combo = 2 * i + ((c & 7) >> 2); row0 = CTXN + 128 * (((c & 3) << 5) + (c >> 3)); nt = 260; } else if (i == 4 && c >= 240) { const int cc = c - 240; combo = cc >> 1; row0 = 128 * (cc & 1); nt = 4; } else break; }
        else { const int u = i * F.G + c; if (u >= 8 * 130) break; combo = u / 130; const int hp = u % 130; row0 = 128 * hp; nt = hp < 2 ? 4 : 260; }
        const int h = combo >> 1, m = combo & 1;
        const bf16* Qb = QKV + (size_t)row0 * ATTN_IN + h * 256 + m * 128;
        const bf16* Kh = QKV + 1024 + h * 256 + m * 128;
        const bf16* Vh = QKV + 2048 + h * 256;
        float* Ob = OA + (size_t)row0 * 2048 + h * 512 + m * 256;
        att::attn_pair_body<ATTN_IN, ATTN_IN, 2048>(Qb, Kh, Vh, Ob, nt, lds, F.tid);
    }
}
__device__ __forceinline__ void swa_phase(const Frame& F, const bf16* QKV, float* OB, const float* sink) {
    char* lds = (char*)(unsigned char*)F.lds;
    for (int u = blockIdx.x; u < 8 * 65; u += F.G) {
        const int hq = u < 512 ? u >> 6 : u - 512, p = u < 512 ? 1 + (u & 63) : 0, kv = hq >> 2;
        const bf16* Qb = QKV + (size_t)(p * 256) * ATTN_IN + 3072 + hq * 128;
        const bf16* Kh = QKV + 4096 + kv * 128;
        const bf16* Vh = QKV + 4352 + kv * 128;
        float* Ob = OB + (size_t)(p * 256) * 1024 + hq * 128;
        int NT = 4, wb = 0, q0 = 0;
        if (p > 0) { q0 = (p - 1) * 256; const int lo = q0 - 128 < 0 ? 0 : q0 - 128, hi = q0 + 384 > SEQ ? SEQ : q0 + 384; wb = CTXN + lo; NT = 4 + (hi - lo) / 64; }
        att::attn_body<true, ATTN_IN, ATTN_IN, 1024, 1>(Qb, Kh, Vh, Ob, NT, wb, q0, sink[hq] * 1.4426950408889634f, lds, F.tid);
    }
}

constexpr int SLOTS = 11, N_PHASES = 2 + DEPTH * SLOTS;
#ifndef REP_GIN
#define REP_GIN 1
#endif
#ifndef REP_GUP
#define REP_GUP 1
#endif
#ifndef REP_GDN
#define REP_GDN 1
#endif
#ifndef REP_GOUT
#define REP_GOUT 1
#endif
#ifndef REP_DK
#define REP_DK 1
#endif
#ifndef REP_DS
#define REP_DS 1
#endif
#ifndef REP_ATT
#define REP_ATT 1
#endif
#ifndef REP_SWA
#define REP_SWA 1
#endif
#ifndef REP_THIN
#define REP_THIN 1
#endif
#ifndef REP_CONV
#define REP_CONV REP_THIN
#endif
#ifndef REP_DNCONV
#define REP_DNCONV REP_THIN
#endif
__global__ void __launch_bounds__(NWAVES * 64, 2) fwd_kernel(Args args) {
    extern __shared__ __attribute__((aligned(16))) unsigned char lds_raw[];
    Frame F;
    F.lds = (LAS unsigned char*)lds_raw;
    F.tid = threadIdx.x; F.lane = F.tid & 63; F.wave = __builtin_amdgcn_readfirstlane(F.tid >> 6);
    F.G = gridDim.x; F.gw = blockIdx.x * NWAVES + F.wave; F.NGW = F.G * NWAVES;
    volatile LAS unsigned* MISC = (volatile LAS unsigned*)(F.lds + MISC_OFF);
    if (F.tid < 64) MISC[F.tid] = 0u;
    if (F.tid < 24) *(LAS unsigned long long*)(F.lds + ARGT_OFF + F.tid * 8) = (unsigned long long)(F.tid < 23 ? (const void*)args.in[F.tid] : (const void*)args.out);
    __syncthreads();
    unsigned char* ws = args.ws;
    XcdBarrier bar; bar.bar = (unsigned*)(ws + WS_CTL) + CW_BAR; bar.x = 0; bar.st = nullptr;
    if (args.use_bar) bar = xcd_barrier_post((unsigned*)(ws + WS_CTL) + CW_BAR, MISC + 8);
    const int lo = args.ph_lo, hi = args.ph_hi;
#define IN(k) (lo <= (k) && (k) < hi)
#define RELAUNDER() do { int t_ = threadIdx.x; asm volatile("" : "+v"(t_)); F.tid = t_; F.lane = t_ & 63; F.wave = __builtin_amdgcn_readfirstlane(t_ >> 6); F.gw = blockIdx.x * NWAVES + F.wave; } while (0)
#define SEAM(k) do { if ((k) + 1 < hi) xcd_barrier(bar); } while (0)

    float* X = (float*)(ws + WS_X); bf16* H = (bf16*)(ws + WS_H);
    const float* MOD = (const float*)(ws + WS_MOD);
    bf16* WIN = (bf16*)(ws + WS_WIN); bf16* WOUT = (bf16*)(ws + WS_WOUT); bf16* WUP = (bf16*)(ws + WS_WUP); bf16* WDN = (bf16*)(ws + WS_WDN);

    if (IN(0)) { RELAUNDER(); p0_prologue(F, ws); SEAM(0); }

    for (int layer = 0; layer < DEPTH; ++layer) {
        const int pb = 1 + layer * SLOTS, li = layer >> 1;
        const float* mod_lat = MOD + (size_t)(layer * 2 + 0) * 12288; const float* mod_ctx = MOD + (size_t)(layer * 2 + 1) * 12288;
        if (IN(pb + 0)) { RELAUNDER();
            for (int rep_ = 0; rep_ < REP_THIN; ++rep_) { norm_phase(F, X, H, AIN(I_N1G) + layer * DM, mod_lat, mod_ctx, 0, (const float*)(ws + WS_P), layer > 0 ? FFH / 256 : 0, MOD + (size_t)((layer - 1) * 2 + 1) * 12288 + 5 * 2048); }
            for (int rep_ = 0; rep_ < REP_CONV; ++rep_) { convert_layer_weights(F, ws, layer); }
            SEAM(pb + 0); }
        if ((layer & 1) == 0) {
            bf16* QKV = (bf16*)(ws + WS_QKV); float* OA = (float*)(ws + WS_OA); float* OB = (float*)(ws + WS_OB); bf16* HM = (bf16*)(ws + WS_HM_ATT);
            if (IN(pb + 1)) { RELAUNDER();
                pg8::Gemm g{H, WIN, MR, ATTN_IN, DM, DM}; pg8::StaticOrder S; S.init(MR, ATTN_IN, F.G, (int)blockIdx.x);
                pg8::EpiQKV E{QKV, ATTN_IN, (const float*)(ws + WS_ROPE)};
                pg8::gemm_phase<pg8::EpiQKV, pg8::StaticOrder, true, true>(F.lds, g, S, E, F.tid);
                SEAM(pb + 1);
            }
            if (IN(pb + 2)) { RELAUNDER();
                for (int rep_ = 0; rep_ < REP_ATT; ++rep_) { diffattn_phase(F, QKV, OA); }
                for (int rep_ = 0; rep_ < REP_SWA; ++rep_) { swa_phase(F, QKV, OB, AIN(I_SINK) + li * 8); }
                SEAM(pb + 2); }
            if (IN(pb + 3)) { RELAUNDER();
                for (int rep_ = 0; rep_ < REP_THIN; ++rep_) { merge_phase(F, OA, OB, HM, AIN(I_SUBLN) + li * 256, ((const float*)(ws + WS_LAM))[li], li == 0 ? 0.2f : 0.4707130183435842f); }
                SEAM(pb + 3); }
            if (IN(pb + 4)) { RELAUNDER();
                { pg8::Gemm g{HM + (size_t)CTXN * DM, WOUT, SEQ, DM, DM, DM}; pg8::StaticOrder S; S.init(SEQ, DM, F.G, (int)blockIdx.x);
                  pg8::EpiResid E{X + (size_t)CTXN * DM, DM, mod_lat + 2 * 2048, mod_lat + 2 * 2048};
                  pg8::gemm_phase<pg8::EpiResid, pg8::StaticOrder, true, true>(F.lds, g, S, E, F.tid); }
                RELAUNDER();
                { int ksl = 256; asm volatile("" : "+s"(ksl)); pg8::Gemm g{HM, WOUT, CTXN, DM, ksl, DM}; pg8::SliceOrder S; S.init(DM, DM / 256, 256, F.G, (int)blockIdx.x);
                  pg8::EpiPart E{(float*)(ws + WS_P), DM};
                  pg8::gemm_phase<pg8::EpiPart, pg8::SliceOrder, true, true>(F.lds, g, S, E, F.tid); }
                SEAM(pb + 4);
            }
        } else {
            bf16* RAW = (bf16*)(ws + WS_RAW); bf16* Z = (bf16*)(ws + WS_Z); float* GATES = (float*)(ws + WS_GATES); bf16* QKRM = (bf16*)(ws + WS_QKRM);
            float* BG = (float*)(ws + WS_BG); bf16* O = (bf16*)(ws + WS_O); bf16* HM = (bf16*)(ws + WS_HM_DN);
            unsigned char* QF = ws + WS_QF; unsigned char* KT = ws + WS_KT; unsigned char* VT = ws + WS_VT; unsigned char* ITEMS = ws + WS_ITEMS;
            if (IN(pb + 1)) { RELAUNDER();
                pg8::Gemm g{H, WIN, MR, DN_INP, DM, DM}; pg8::StaticOrder S; S.init(MR, DN_INP, F.G, (int)blockIdx.x);
                pg8::EpiDnIn E{RAW, Z, GATES};
                pg8::gemm_phase<pg8::EpiDnIn, pg8::StaticOrder, true, true>(F.lds, g, S, E, F.tid);
                SEAM(pb + 1);
            }
            if (IN(pb + 2)) { RELAUNDER();
                for (int rep_ = 0; rep_ < REP_DNCONV; ++rep_) { dnconv2_phase(F, RAW, QKRM, QF, KT, VT, AIN(I_DCONV) + (size_t)li * 3 * 8192, GATES, BG, AIN(I_DALOG) + li * 64, AIN(I_DDT) + li * 64); }
                SEAM(pb + 2); }
            if (IN(pb + 3)) { RELAUNDER(); for (int rep_ = 0; rep_ < REP_DK; ++rep_) { dk_phase(F, QKRM, KT, VT, BG, ITEMS); } SEAM(pb + 3); }
            if (IN(pb + 4)) { RELAUNDER(); for (int rep_ = 0; rep_ < REP_DS; ++rep_) { ds_phase(F, ITEMS, QF, KT, O); } SEAM(pb + 4); }
            if (IN(pb + 5)) { RELAUNDER(); for (int rep_ = 0; rep_ < REP_THIN; ++rep_) { dnout2_phase(F, O, Z, HM, AIN(I_DNG) + li * 128); } SEAM(pb + 5); }
            if (IN(pb + 6)) { RELAUNDER();
                { pg8::Gemm g{HM + (size_t)CTXN * 4096, WOUT, SEQ, DM, 4096, 4096}; pg8::StaticOrder S; S.init(SEQ, DM, F.G, (int)blockIdx.x);
                  pg8::EpiResid E{X + (size_t)CTXN * DM, DM, mod_lat + 2 * 2048, mod_lat + 2 * 2048};
                  pg8::gemm_phase<pg8::EpiResid, pg8::StaticOrder, true, true>(F.lds, g, S, E, F.tid); }
                RELAUNDER();
                if (layer != DEPTH - 1) { int ksl = 256; asm volatile("" : "+s"(ksl)); pg8::Gemm g{HM, WOUT, CTXN, DM, ksl, 4096}; pg8::SliceOrder S; S.init(DM, 4096 / 256, 256, F.G, (int)blockIdx.x);
                  pg8::EpiPart E{(float*)(ws + WS_P), DM};
                  pg8::gemm_phase<pg8::EpiPart, pg8::SliceOrder, true, true>(F.lds, g, S, E, F.tid); }
                SEAM(pb + 6);
            }
        }
        if (IN(pb + 7)) { RELAUNDER(); for (int rep_ = 0; rep_ < REP_THIN; ++rep_) { norm_phase(F, X, H, AIN(I_N2G) + layer * DM, mod_lat, mod_ctx, 3, (const float*)(ws + WS_P), layer == DEPTH - 1 ? 0 : ((layer & 1) ? 4096 / 256 : DM / 256), mod_ctx + 2 * 2048); } SEAM(pb + 7); }
        if (IN(pb + 8)) { RELAUNDER();
            const int mofs = (layer == DEPTH - 1) ? CTXN : 0;
            pg8::Gemm g{H + (size_t)mofs * DM, WUP, MR - mofs, FFU, DM, DM}; pg8::StaticOrder S; S.init(MR - mofs, FFU, F.G, (int)blockIdx.x);
            pg8::EpiBf16 E{(bf16*)(ws + WS_U) + (size_t)mofs * FFU, FFU};
            pg8::gemm_phase<pg8::EpiBf16, pg8::StaticOrder, true, true>(F.lds, g, S, E, F.tid);
            SEAM(pb + 8);
        }
        if (IN(pb + 9)) { RELAUNDER(); for (int rep_ = 0; rep_ < REP_THIN; ++rep_) { convgate_phase(F, (const bf16*)(ws + WS_U), (bf16*)(ws + WS_A2), AIN(I_FCONV) + (size_t)layer * 3 * FFU, layer == DEPTH - 1 ? CTXN / 32 : 0); } SEAM(pb + 9); }
        if (IN(pb + 10)) { RELAUNDER();
            { pg8::Gemm g{(const bf16*)(ws + WS_A2) + (size_t)CTXN * FFH, WDN, SEQ, DM, FFH, FFH}; pg8::StaticOrder S; S.init(SEQ, DM, F.G, (int)blockIdx.x);
              pg8::EpiResid E{X + (size_t)CTXN * DM, DM, mod_lat + 5 * 2048, mod_lat + 5 * 2048};
              pg8::gemm_phase<pg8::EpiResid, pg8::StaticOrder, true, true>(F.lds, g, S, E, F.tid); }
            RELAUNDER();
            if (layer != DEPTH - 1) { int ksl = 256; asm volatile("" : "+s"(ksl)); pg8::Gemm g{(const bf16*)(ws + WS_A2), WDN, CTXN, DM, ksl, FFH}; pg8::SliceOrder S; S.init(DM, FFH / 256, 256, F.G, (int)blockIdx.x);
              pg8::EpiPart E{(float*)(ws + WS_P), DM};
              pg8::gemm_phase<pg8::EpiPart, pg8::SliceOrder, true, true>(F.lds, g, S, E, F.tid); }
            SEAM(pb + 10);
        }
    }
    if (IN(N_PHASES - 1)) { RELAUNDER(); final_phase(F, X, (float*)AIN(23), AIN(I_FING)); }
#undef IN
#undef SEAM
#undef RELAUNDER
}

#ifndef MK_ONE_LAUNCH
#define MK_ONE_LAUNCH 1
#endif
extern "C" void kernel_launch(void* const* d_in, const int* in_sizes, int n_in, void* d_out, int out_size, void* d_ws, size_t ws_size, hipStream_t stream) {
    static int grid = 0;
    if (grid == 0) {
        if (n_in != 23 || out_size != SEQ * DM || ws_size < WS_END) { fprintf(stderr, "kernel_launch: unexpected problem: n_in %d out %d ws %zu (need %zu)\n", n_in, out_size, ws_size, (size_t)WS_END); grid = -1; return; }
        int dev = 0, cus = 0, per_cu = 0;
        if (hipGetDevice(&dev) != hipSuccess || hipDeviceGetAttribute(&cus, hipDeviceAttributeMultiprocessorCount, dev) != hipSuccess) { grid = -1; return; }
        if (hipFuncSetAttribute((const void*)fwd_kernel, hipFuncAttributeMaxDynamicSharedMemorySize, LDS_BYTES) != hipSuccess) { fprintf(stderr, "kernel_launch: hipFuncSetAttribute failed\n"); grid = -1; return; }
        if (hipOccupancyMaxActiveBlocksPerMultiprocessor(&per_cu, (const void*)fwd_kernel, NWAVES * 64, LDS_BYTES) != hipSuccess || per_cu < 1) { fprintf(stderr, "kernel_launch: occupancy query reports %d blocks per CU\n", per_cu); }
        (void)hipGetLastError();
        grid = cus;
    }
    if (grid < 0) return;
    (void)hipMemsetAsync((char*)d_ws + WS_CTL, 0, CTL_ZERO_BYTES, stream);
    Args a{};
    for (int i = 0; i < 23; ++i) a.in[i] = (const float*)d_in[i];
    a.out = (float*)d_out; a.ws = (unsigned char*)d_ws; a.pad = 0;
#if MK_ONE_LAUNCH
    a.ph_lo = 0; a.ph_hi = N_PHASES; a.use_bar = 1;
    hipLaunchKernelGGL(fwd_kernel, dim3(grid), dim3(NWAVES * 64), LDS_BYTES, stream, a);
#else
    for (int ph = 0; ph < N_PHASES; ++ph) {
        if (ph >= 1 && ph < N_PHASES - 1) { const int layer = (ph - 1) / SLOTS, slot = (ph - 1) % SLOTS; if ((layer & 1) == 0 && (slot == 5 || slot == 6)) continue; }
        a.ph_lo = ph; a.ph_hi = ph + 1; a.use_bar = 0;
        hipLaunchKernelGGL(fwd_kernel, dim3(grid), dim3(NWAVES * 64), LDS_BYTES, stream, a);
    }
#endif
    const hipError_t le = hipPeekAtLastError();
    if (le != hipSuccess) fprintf(stderr, "kernel_launch: launch failed: %s\n", hipGetErrorName(le));
}
```
